# Optimizing an MI355X kernel written in HIP

```python
import math
import jax
import jax.numpy as jnp
from jax import lax
import numpy as np

D_MODEL = 1024
BATCH = 4
SEQ = 8192
DEPTH = 2

D_MIX = D_MODEL
POOL_W = D_MIX // 4
POOL_WINDOWS = (2, 4, 8, 16)
POOL_GROUP = POOL_W // len(POOL_WINDOWS)
DIFF_HEADS = 4
DIFF_QK_DIM = 32
DIFF_V_DIM = 2 * DIFF_QK_DIM
DIFF_W = DIFF_HEADS * DIFF_V_DIM
Q_BLOCK = 128
SSD_INNER = D_MIX - POOL_W - DIFF_W
SSD_HEAD_DIM = 64
SSD_HEADS = SSD_INNER // SSD_HEAD_DIM
SSD_GROUPS = 2
SSD_HEADS_PER_GROUP = SSD_HEADS // SSD_GROUPS
SSD_STATE = 128
CONV_K = 4
CONV_CH = SSD_INNER + 2 * SSD_GROUPS * SSD_STATE
CHUNK = 128
D_FF = 4 * D_MODEL
PLE_DIM = 256
ALPHA = (2 * DEPTH) ** 0.25
BETA = (8 * DEPTH) ** -0.25
LN_EPS = 1e-5
IN_SIZES = (POOL_W, DIFF_HEADS * 2 * DIFF_QK_DIM, DIFF_HEADS * 2 * DIFF_QK_DIM, DIFF_W,
            SSD_INNER, CONV_CH, SSD_HEADS)
IN_W = sum(IN_SIZES)

kernel_name = 'hymba_style_pool_diffattn_ssd_deepnorm'


def layer_norm(x, g, b):
    xf = x.astype(jnp.float32)
    mu = jnp.mean(xf, axis=-1, keepdims=True)
    xc = xf - mu
    var = jnp.mean(xc * xc, axis=-1, keepdims=True)
    y = xc * lax.rsqrt(var + LN_EPS) * g.astype(jnp.float32) + b.astype(jnp.float32)
    return y.astype(x.dtype)


def rms_norm(x, g):
    xf = x.astype(jnp.float32)
    y = xf * lax.rsqrt(jnp.mean(xf * xf, axis=-1, keepdims=True) + LN_EPS)
    return y * g.astype(jnp.float32)


def split_cols(a, sizes):
    out = []
    o = 0
    for s in sizes:
        out.append(a[..., o:o + s])
        o += s
    return out


def multiscale_pool(u, w_grp, scale):
    Bsz, S, _ = u.shape
    uf = u.astype(jnp.float32)
    cs = jnp.cumsum(uf, axis=1)
    pos = jnp.arange(1, S + 1, dtype=jnp.float32)
    outs = []
    for gi, w in enumerate(POOL_WINDOWS):
        sl = slice(gi * POOL_GROUP, (gi + 1) * POOL_GROUP)
        csg = cs[..., sl]
        lag = jnp.pad(csg, ((0, 0), (w, 0), (0, 0)))[:, :S]
        cnt = jnp.minimum(pos, float(w))[None, :, None]
        outs.append((csg - lag) / cnt - uf[..., sl])
    pooled = jnp.stack(outs, axis=2)
    mixed = jnp.einsum('bsgc,gcd->bsgd', pooled, w_grp.astype(jnp.float32)).reshape(Bsz, S, POOL_W)
    return (mixed * scale.astype(jnp.float32)).astype(u.dtype)


def diff_attention(q, k, v, lam_q1, lam_k1, lam_q2, lam_k2, norm_g, lambda_init):
    Bsz, S, _ = q.shape
    dtype = q.dtype
    q = q.reshape(Bsz, S, DIFF_HEADS, 2, DIFF_QK_DIM).transpose(0, 2, 3, 1, 4) * (DIFF_QK_DIM ** -0.5)
    k = k.reshape(Bsz, S, DIFF_HEADS, 2, DIFF_QK_DIM).transpose(0, 2, 3, 1, 4)
    vf = v.reshape(Bsz, S, DIFF_HEADS, DIFF_V_DIM).transpose(0, 2, 1, 3).astype(jnp.float32)
    f32 = jnp.float32
    lam = (jnp.exp(jnp.sum(lam_q1.astype(f32) * lam_k1.astype(f32)))
           - jnp.exp(jnp.sum(lam_q2.astype(f32) * lam_k2.astype(f32))) + lambda_init)
    nblk = S // Q_BLOCK
    qb = q.reshape(Bsz, DIFF_HEADS, 2, nblk, Q_BLOCK, DIFF_QK_DIM).transpose(3, 0, 1, 2, 4, 5)
    kpos = jnp.arange(S)

    def block(args):
        qi, bi = args
        s = jnp.einsum('bhjqd,bhjkd->bhjqk', qi, k).astype(f32)
        qpos = bi * Q_BLOCK + jnp.arange(Q_BLOCK)
        mask = kpos[None, :] <= qpos[:, None]
        s = jnp.where(mask, s, -jnp.inf)
        a = jax.nn.softmax(s, axis=-1)
        w = a[:, :, 0] - lam * a[:, :, 1]
        return jnp.einsum('bhqk,bhkv->bhqv', w, vf)

    o = lax.map(block, (qb, jnp.arange(nblk)))
    o = o.transpose(1, 0, 3, 2, 4).reshape(Bsz, S, DIFF_HEADS, DIFF_V_DIM)
    o = rms_norm(o, norm_g) * (1.0 - lambda_init)
    return o.reshape(Bsz, S, DIFF_W).astype(dtype)


def causal_depthwise_conv(x, w, b):
    C = x.shape[-1]
    y = lax.conv_general_dilated(x, w[:, None, :].astype(x.dtype), window_strides=(1,),
                                 padding=((CONV_K - 1, 0),), dimension_numbers=('NWC', 'WIO', 'NWC'),
                                 feature_group_count=C)
    return y + b.astype(x.dtype)


def ssd_mixer(z, xbc, dt_raw, conv_w, conv_b, dt_bias, a_log, d_skip, norm_g):
    Bsz, S, _ = xbc.shape
    dtype = xbc.dtype
    f32 = jnp.float32
    G, R, P, N, Lc = SSD_GROUPS, SSD_HEADS_PER_GROUP, SSD_HEAD_DIM, SSD_STATE, CHUNK
    nc = S // Lc
    xbc = jax.nn.silu(causal_depthwise_conv(xbc, conv_w, conv_b))
    xs, Bm, Cm = split_cols(xbc, (SSD_INNER, G * N, G * N))
    xs = xs.astype(f32).reshape(Bsz, nc, Lc, G, R, P)
    Bm = Bm.astype(f32).reshape(Bsz, nc, Lc, G, N)
    Cm = Cm.astype(f32).reshape(Bsz, nc, Lc, G, N)
    dt = jax.nn.softplus(dt_raw.astype(f32) + dt_bias.astype(f32)).reshape(Bsz, nc, Lc, G, R)
    A = -jnp.exp(a_log.astype(f32)).reshape(G, R)
    xdt = xs * dt[..., None]
    acs = jnp.cumsum(dt * A, axis=2).transpose(0, 1, 3, 4, 2)
    seg = acs[..., :, None] - acs[..., None, :]
    tril = jnp.tril(jnp.ones((Lc, Lc), dtype=bool))
    Lmat = jnp.exp(jnp.where(tril, seg, -jnp.inf))
    CB = jnp.einsum('bclgn,bcsgn->bcgls', Cm, Bm)
    y_diag = jnp.einsum('bcgls,bcgrls,bcsgrp->bclgrp', CB, Lmat, xdt)
    decay_states = jnp.exp(acs[..., -1:] - acs)
    states = jnp.einsum('bclgn,bcgrl,bclgrp->bcgrpn', Bm, decay_states, xdt)
    chunk_decay = jnp.exp(acs[..., -1])

    def step(h, inp):
        st, dec = inp
        return h * dec[..., None, None] + st, h

    h0 = jnp.zeros((Bsz, G, R, P, N), f32)
    _, prev = lax.scan(step, h0, (jnp.moveaxis(states, 1, 0), jnp.moveaxis(chunk_decay, 1, 0)))
    prev = jnp.moveaxis(prev, 0, 1)
    y_off = jnp.einsum('bclgn,bcgrpn,bcgrl->bclgrp', Cm, prev, jnp.exp(acs))
    y = y_diag + y_off + xs * d_skip.astype(f32).reshape(G, R)[:, :, None]
    y = y.reshape(Bsz, S, SSD_INNER) * jax.nn.silu(z.astype(f32))
    return rms_norm(y, norm_g).astype(dtype)


def setup_inputs(seed: int = 0) -> dict:
    key = jax.random.key(seed)
    ks = jax.random.split(key, 32)
    L = DEPTH
    f32 = jnp.float32

    def nrm(k, shape):
        return jax.random.normal(k, shape, f32)

    x = nrm(ks[0], (BATCH, SEQ, D_MODEL))
    p = nrm(ks[1], (DEPTH, BATCH, SEQ, PLE_DIM))
    ln_in_g = 1.0 + 0.02 * nrm(ks[2], (D_MODEL,))
    ln_in_b = 0.02 * nrm(ks[3], (D_MODEL,))
    w_in = nrm(ks[4], (L, D_MODEL, IN_W)) * (D_MODEL ** -0.5)
    pool_w = nrm(ks[5], (L, len(POOL_WINDOWS), POOL_GROUP, POOL_GROUP)) * (POOL_GROUP ** -0.5)
    pool_scale = 1.0 + 0.02 * nrm(ks[6], (L, POOL_W))
    lam_q1 = 0.1 * nrm(ks[7], (L, DIFF_QK_DIM))
    lam_k1 = 0.1 * nrm(ks[8], (L, DIFF_QK_DIM))
    lam_q2 = 0.1 * nrm(ks[9], (L, DIFF_QK_DIM))
    lam_k2 = 0.1 * nrm(ks[10], (L, DIFF_QK_DIM))
    diff_norm_g = 1.0 + 0.02 * nrm(ks[11], (L, DIFF_V_DIM))
    conv_w = nrm(ks[12], (L, CONV_K, CONV_CH)) * (CONV_K ** -0.5)
    conv_b = 0.02 * nrm(ks[13], (L, CONV_CH))
    dt0 = jnp.exp(jax.random.uniform(ks[14], (L, SSD_HEADS), f32, minval=math.log(1e-3), maxval=math.log(1e-1)))
    dt_bias = dt0 + jnp.log(-jnp.expm1(-dt0))
    a_log = jnp.log(jax.random.uniform(ks[15], (L, SSD_HEADS), f32, minval=1.0, maxval=16.0))
    d_skip = 1.0 + 0.02 * nrm(ks[16], (L, SSD_HEADS))
    ssd_norm_g = 1.0 + 0.02 * nrm(ks[17], (L, SSD_INNER))
    w_out = nrm(ks[18], (L, D_MIX, D_MODEL)) * (D_MIX ** -0.5 * BETA)
    ln1_g = 1.0 + 0.02 * nrm(ks[19], (L, D_MODEL))
    ln1_b = 0.02 * nrm(ks[20], (L, D_MODEL))
    w_ff1 = nrm(ks[21], (L, D_MODEL, D_FF)) * (D_MODEL ** -0.5)
    w_ff2 = nrm(ks[22], (L, D_FF, D_MODEL)) * (D_FF ** -0.5 * BETA)
    w_ple = nrm(ks[23], (L, PLE_DIM, D_MODEL)) * (PLE_DIM ** -0.5 * BETA)
    w_ple_gate = nrm(ks[24], (L, D_MODEL, D_MODEL)) * (D_MODEL ** -0.5)
    ln2_g = 1.0 + 0.02 * nrm(ks[25], (L, D_MODEL))
    ln2_b = 0.02 * nrm(ks[26], (L, D_MODEL))
    return {'x': x, 'p': p, 'ln_in_g': ln_in_g, 'ln_in_b': ln_in_b, 'w_in': w_in,
            'pool_w': pool_w, 'pool_scale': pool_scale,
            'lam_q1': lam_q1, 'lam_k1': lam_k1, 'lam_q2': lam_q2, 'lam_k2': lam_k2, 'diff_norm_g': diff_norm_g,
            'conv_w': conv_w, 'conv_b': conv_b, 'dt_bias': dt_bias, 'a_log': a_log, 'd_skip': d_skip,
            'ssd_norm_g': ssd_norm_g, 'w_out': w_out, 'ln1_g': ln1_g, 'ln1_b': ln1_b,
            'w_ff1': w_ff1, 'w_ff2': w_ff2, 'w_ple': w_ple, 'w_ple_gate': w_ple_gate,
            'ln2_g': ln2_g, 'ln2_b': ln2_b}


def reference(x, p, ln_in_g, ln_in_b, w_in, pool_w, pool_scale, lam_q1, lam_k1, lam_q2, lam_k2, diff_norm_g,
              conv_w, conv_b, dt_bias, a_log, d_skip, ssd_norm_g, w_out, ln1_g, ln1_b,
              w_ff1, w_ff2, w_ple, w_ple_gate, ln2_g, ln2_b):
    h = layer_norm(x, ln_in_g, ln_in_b)
    for i in range(DEPTH):
        lambda_init = 0.8 - 0.6 * math.exp(-0.3 * i)
        proj = h @ w_in[i]
        u_pool, q, k, v, z, xbc, dt_raw = split_cols(proj, IN_SIZES)
        o_pool = multiscale_pool(u_pool, pool_w[i], pool_scale[i])
        o_diff = diff_attention(q, k, v, lam_q1[i], lam_k1[i], lam_q2[i], lam_k2[i], diff_norm_g[i], lambda_init)
        o_ssd = ssd_mixer(z, xbc, dt_raw, conv_w[i], conv_b[i], dt_bias[i], a_log[i], d_skip[i], ssd_norm_g[i])
        mix = jnp.concatenate([o_pool, o_diff, o_ssd], axis=-1) @ w_out[i]
        h = layer_norm(ALPHA * h + mix, ln1_g[i], ln1_b[i])
        ff = jnp.square(jax.nn.relu(h @ w_ff1[i])) @ w_ff2[i]
        ple = (p[i] @ w_ple[i]) * jax.nn.sigmoid(h @ w_ple_gate[i])
        h = layer_norm(ALPHA * h + ff + ple, ln2_g[i], ln2_b[i])
    return h
```

```cpp
#include <hip/hip_runtime.h>
#include <hip/hip_cooperative_groups.h>
#include <cstdio>
#include <cstdint>
namespace cg = cooperative_groups;
namespace pg8 {
#define PG8_LAS __attribute__((address_space(3)))
typedef unsigned short bf16_t;
typedef short bf16x8 __attribute__((ext_vector_type(8)));
typedef float f32x4 __attribute__((ext_vector_type(4)));
typedef unsigned u32x4 __attribute__((ext_vector_type(4)));
constexpr int BM = 256, BK = 64, HALF = 128, HTB = HALF * BK * 2  , STAGE_BYTES = 8 * HTB, NXCD = 8, WGM = 8;

__host__ __device__ __forceinline__ int lds_byte(int r, int c) { const int st = (r >> 4) * 2 + (c >> 5), rr = r & 15, cc = c & 31, ob = rr * 64 + cc * 2; return st * 1024 + (ob ^ (((ob >> 9) & 1) << 5)); }
__host__ __device__ __forceinline__ void stage_rc(int b, int& R, int& C) { const int st = b / 1024, sb = b % 1024, swz = sb ^ (((sb >> 9) & 1) << 5); R = (st >> 1) * 16 + swz / 64; C = (st & 1) * 32 + (swz % 64) / 2; }
__host__ __device__ __forceinline__ int perm32(int rho) { const int n = rho >> 4, i = rho & 15; return 8 * (i >> 2) + 4 * n + (i & 3); }

struct Unit { int pm, pn; };
struct Gemm { const bf16_t* A; const bf16_t* Bt; int M, N, K; };

struct StaticOrder {
    int nM, nN, nwg, G, c;
    __host__ __device__ void init(int M, int N, int G_, int c_) { nM = M / BM; nN = N / BM; nwg = nM * nN; G = G_; c = c_; }
    __host__ __device__ bool next(int i, Unit& u) const {
        const long L = (long)i * G + c; if (L >= nwg) return false;
        int wgid = (int)L; { const int q = nwg / NXCD, r = nwg % NXCD, xcd = wgid % NXCD, off = wgid / NXCD; wgid = (xcd < r ? xcd * (q + 1) : r * (q + 1) + (xcd - r) * q) + off; }
        const int nig = WGM * nN, gid = wgid / nig, fm = gid * WGM, gsz = (nM - fm) < WGM ? (nM - fm) : WGM;
        u.pm = fm + ((wgid % nig) % gsz); u.pn = (wgid % nig) / gsz; return true;
    }
    __device__ __forceinline__ void a_ready(const Unit&) const {}
    __device__ __forceinline__ void done(const Unit&) const {}
};
__device__ __forceinline__ unsigned cvt_pk_bf16(float lo, float hi) { unsigned r; asm volatile("v_cvt_pk_bf16_f32 %0, %1, %2" : "=v"(r) : "v"(lo), "v"(hi)); return r; }
typedef float f32x2 __attribute__((ext_vector_type(2)));
template <class Epi, class Sched, bool ALIGN_EPI = false, bool SP2 = false>
__device__ __forceinline__ void gemm_phase(PG8_LAS unsigned char* lds, const Gemm g, const Sched& S, const Epi& E, const int tid_in) {
    const int tid = tid_in, wid = __builtin_amdgcn_readfirstlane(tid >> 6), lane = tid & 63, wr = wid >> 2, wc = wid & 3, fr = lane & 15, fq = lane >> 4;
    const int K = g.K, nt = K / BK;
    unsigned voffA[2], voffB[2];
#pragma unroll
    for (int i = 0; i < 2; ++i) { int R, C; stage_rc(tid * 16 + i * 8192, R, C); const int Rb = Epi::PERM ? ((R & ~31) + perm32(R & 31)) : R;
        voffA[i] = (unsigned)(R * K + C) * 2u; voffB[i] = (unsigned)(Rb * K + C) * 2u; }
    const size_t kstep = (size_t)(BK * 2);
    const size_t hstep = (size_t)HALF * K * 2;
    const size_t tstep = 2 * hstep;
    const unsigned ldsw = (unsigned)wid * 1024u;
    const int aoff = lds_byte(wr * 64 + fr, fq * 8), boff = lds_byte(wc * 32 + fr, fq * 8);
#define PG8_SA(b, h) (((b) * 2 + (h)) * HTB)
#define PG8_SB(b, h) ((4 + (b) * 2 + (h)) * HTB)
#define PG8_STAGE(bufoff, gbase, voff) do { _Pragma("unroll") for (int _i = 0; _i < 2; ++_i) \
        __builtin_amdgcn_global_load_lds((const unsigned*)((const char*)(gbase) + (voff)[_i]), (PG8_LAS unsigned*)(lds + (bufoff) + ldsw + _i * 8192), 16, 0, 0); } while (0)
#define PG8_LDA(dst, b, h) do { _Pragma("unroll") for (int m = 0; m < 4; ++m) _Pragma("unroll") for (int k = 0; k < 2; ++k) dst[m][k] = *(const PG8_LAS bf16x8*)(lds + PG8_SA(b, h) + aoff + m * 2048 + k * 1024); } while (0)
#define PG8_LDB(dst, b, h) do { _Pragma("unroll") for (int n = 0; n < 2; ++n) _Pragma("unroll") for (int k = 0; k < 2; ++k) dst[n][k] = *(const PG8_LAS bf16x8*)(lds + PG8_SB(b, h) + boff + n * 2048 + k * 1024); } while (0)
#define PG8_MMA(ai, bj, At, Bt) do { __builtin_amdgcn_s_setprio(1); _Pragma("unroll") for (int m = 0; m < 4; ++m) _Pragma("unroll") for (int n = 0; n < 2; ++n) _Pragma("unroll") for (int k = 0; k < 2; ++k) \
        acc[ai][bj][m][n] = __builtin_amdgcn_mfma_f32_16x16x32_bf16(Bt[n][k], At[m][k], acc[ai][bj][m][n], 0, 0, 0); __builtin_amdgcn_s_setprio(0); } while (0)
#define PG8_WAIT_V(n) asm volatile("s_waitcnt vmcnt(" #n ")" ::: "memory")
#define PG8_WAIT_L(n) asm volatile("s_waitcnt lgkmcnt(" #n ")" ::: "memory")
#define PG8_BAR __builtin_amdgcn_s_barrier()
#define PG8_SCHED __builtin_amdgcn_sched_barrier(0)
    Unit cur, nxt; int ui = 0;
    if (!S.next(0, cur)) return;
    f32x4 acc[2][2][4][2];
#pragma unroll
    for (int a = 0; a < 2; ++a)
#pragma unroll
        for (int b = 0; b < 2; ++b)
#pragma unroll
            for (int m = 0; m < 4; ++m)
#pragma unroll
                for (int n = 0; n < 2; ++n) acc[a][b][m][n] = (f32x4){0.f, 0.f, 0.f, 0.f};
    bf16x8 At[4][2], B0[2][2], B1[2][2];
    const char* cA = (const char*)g.A + (size_t)cur.pm * tstep; const char* cB = (const char*)g.Bt + (size_t)cur.pn * tstep;
    S.a_ready(cur);
    if constexpr (SP2) {
        PG8_STAGE(PG8_SB(0, 0), cB, voffB); PG8_STAGE(PG8_SB(0, 1), cB + hstep, voffB); PG8_STAGE(PG8_SA(0, 0), cA, voffA); PG8_STAGE(PG8_SA(0, 1), cA + hstep, voffA);
        if (wr == 1) PG8_BAR;
        PG8_WAIT_V(2); PG8_BAR;
        PG8_STAGE(PG8_SB(1, 0), cB + kstep, voffB); PG8_STAGE(PG8_SA(1, 0), cA + kstep, voffA); PG8_STAGE(PG8_SB(1, 1), cB + hstep + kstep, voffB);
        PG8_WAIT_V(6); PG8_BAR;
    } else {
        PG8_STAGE(PG8_SB(0, 0), cB, voffB); PG8_STAGE(PG8_SA(0, 0), cA, voffA); PG8_STAGE(PG8_SB(0, 1), cB + hstep, voffB); PG8_STAGE(PG8_SA(0, 1), cA + hstep, voffA);
        if (wr == 1) PG8_BAR;
        PG8_WAIT_V(4); PG8_BAR;
        PG8_STAGE(PG8_SB(1, 0), cB + kstep, voffB); PG8_STAGE(PG8_SA(1, 0), cA + kstep, voffA); PG8_STAGE(PG8_SB(1, 1), cB + hstep + kstep, voffB);
        PG8_WAIT_V(6); PG8_BAR;
    }
    for (;;) {
        const bool has_next = S.next(ui + 1, nxt);
        const char* nA = has_next ? (const char*)g.A + (size_t)nxt.pm * tstep : cA; const char* nB = has_next ? (const char*)g.Bt + (size_t)nxt.pn * tstep : cB;
        for (int t = 0; t < nt; t += 2) {
            const bool last = (t == nt - 2);
            const char* a1 = cA + (size_t)(t + 1) * kstep;
            const char* a2 = last ? nA : cA + (size_t)(t + 2) * kstep; const char* b2 = last ? nB : cB + (size_t)(t + 2) * kstep;
            const char* a3 = a2 + kstep; const char* b3 = b2 + kstep;
            if (last && has_next) S.a_ready(nxt);
            if constexpr (SP2) {
            PG8_LDB(B0, 0, 0); PG8_LDB(B1, 0, 1); PG8_SCHED; PG8_LDA(At, 0, 0); PG8_STAGE(PG8_SA(1, 1), a1 + hstep, voffA);
            PG8_WAIT_V(8); PG8_WAIT_L(0); PG8_BAR; PG8_MMA(0, 0, At, B0); PG8_MMA(0, 1, At, B1); PG8_BAR; PG8_SCHED;
            PG8_LDA(At, 0, 1); PG8_STAGE(PG8_SB(0, 0), b2, voffB); PG8_STAGE(PG8_SB(0, 1), b2 + hstep, voffB); PG8_STAGE(PG8_SA(0, 0), a2, voffA);
            PG8_WAIT_V(8); PG8_WAIT_L(0); PG8_BAR; PG8_MMA(1, 0, At, B0); PG8_MMA(1, 1, At, B1); PG8_BAR; PG8_SCHED;
            PG8_LDB(B0, 1, 0); PG8_LDB(B1, 1, 1); PG8_SCHED; PG8_LDA(At, 1, 0); PG8_STAGE(PG8_SA(0, 1), a2 + hstep, voffA);
            PG8_WAIT_V(8); PG8_WAIT_L(0); PG8_BAR; PG8_MMA(0, 0, At, B0); PG8_MMA(0, 1, At, B1); PG8_BAR; PG8_SCHED;
            PG8_LDA(At, 1, 1); PG8_STAGE(PG8_SB(1, 0), b3, voffB); PG8_STAGE(PG8_SB(1, 1), b3 + hstep, voffB); PG8_STAGE(PG8_SA(1, 0), a3, voffA);
            PG8_WAIT_V(8); PG8_WAIT_L(0); PG8_BAR; PG8_MMA(1, 0, At, B0); PG8_MMA(1, 1, At, B1); PG8_BAR; PG8_SCHED;
            } else {
            PG8_LDB(B0, 0, 0); PG8_SCHED; PG8_LDA(At, 0, 0); PG8_STAGE(PG8_SA(1, 1), a1 + hstep, voffA);
            PG8_WAIT_L(8); PG8_BAR; PG8_WAIT_L(0); PG8_MMA(0, 0, At, B0); PG8_BAR; PG8_SCHED;
            PG8_LDB(B1, 0, 1); PG8_STAGE(PG8_SB(0, 0), b2, voffB);
            PG8_BAR; PG8_WAIT_L(0); PG8_MMA(0, 1, At, B1); PG8_BAR;
            PG8_LDA(At, 0, 1); PG8_STAGE(PG8_SA(0, 0), a2, voffA);
            PG8_BAR; PG8_WAIT_L(0); PG8_MMA(1, 0, At, B0); PG8_BAR; PG8_SCHED;
            PG8_STAGE(PG8_SB(0, 1), b2 + hstep, voffB);
            PG8_WAIT_V(6); PG8_BAR; PG8_MMA(1, 1, At, B1); PG8_BAR;
            PG8_LDB(B0, 1, 0); PG8_SCHED; PG8_LDA(At, 1, 0); PG8_STAGE(PG8_SA(0, 1), a2 + hstep, voffA);
            PG8_WAIT_L(8); PG8_BAR; PG8_WAIT_L(0); PG8_MMA(0, 0, At, B0); PG8_BAR; PG8_SCHED;
            PG8_LDB(B1, 1, 1); PG8_STAGE(PG8_SB(1, 0), b3, voffB);
            PG8_BAR; PG8_WAIT_L(0); PG8_MMA(0, 1, At, B1); PG8_BAR;
            PG8_LDA(At, 1, 1); PG8_STAGE(PG8_SA(1, 0), a3, voffA);
            PG8_BAR; PG8_WAIT_L(0); PG8_MMA(1, 0, At, B0); PG8_BAR; PG8_SCHED;
            PG8_STAGE(PG8_SB(1, 1), b3 + hstep, voffB);
            PG8_WAIT_V(6); PG8_BAR; PG8_MMA(1, 1, At, B1); PG8_BAR;
            }
        }
        if constexpr (ALIGN_EPI) { if (wr == 0) PG8_BAR; }
        if constexpr (!Epi::AFTER_DRAIN) { E(acc, cur, wr, wc, fr, fq); S.done(cur); }
        if (!has_next) break;
#pragma unroll
        for (int a = 0; a < 2; ++a)
#pragma unroll
            for (int b = 0; b < 2; ++b)
#pragma unroll
                for (int m = 0; m < 4; ++m)
#pragma unroll
                    for (int n = 0; n < 2; ++n) acc[a][b][m][n] = (f32x4){0.f, 0.f, 0.f, 0.f};
        cur = nxt; cA = nA; cB = nB; ++ui;
        if constexpr (ALIGN_EPI) { if (wr == 1) PG8_BAR; }
    }
    PG8_WAIT_V(0);
    if constexpr (!ALIGN_EPI) { if (wr == 0) PG8_BAR; }
    PG8_BAR;
    if constexpr (Epi::AFTER_DRAIN) { E.fused(acc, cur, wr, wc, fr, fq, lds, wid, lane); S.done(cur); }
#undef PG8_SA
#undef PG8_SB
#undef PG8_STAGE
#undef PG8_LDA
#undef PG8_LDB
#undef PG8_MMA
#undef PG8_WAIT_V
#undef PG8_WAIT_L
#undef PG8_BAR
#undef PG8_SCHED
}
}

#define LAS __attribute__((address_space(3)))
typedef unsigned short bf16_t;
typedef short bf16x8 __attribute__((ext_vector_type(8)));
typedef short s16x4 __attribute__((ext_vector_type(4)));
typedef float f32x2 __attribute__((ext_vector_type(2)));
typedef float f32x4 __attribute__((ext_vector_type(4)));
typedef float f32x16 __attribute__((ext_vector_type(16)));
typedef unsigned u32x2 __attribute__((ext_vector_type(2)));
typedef unsigned u32x4 __attribute__((ext_vector_type(4)));
#define MFMA32(a, b, c) __builtin_amdgcn_mfma_f32_32x32x16_bf16((a), (b), (c), 0, 0, 0)

constexpr int NWAVES = 8, NTHR = 512;
constexpr int BATCH = 4, SEQ = 8192, DM = 1024, MTOK = BATCH * SEQ, INW = 2568, NPROJ = 2560, DFF = 4096, PLED = 256, DEPTH = 2;
constexpr int C_POOL = 0, C_Q = 256, C_K = 512, C_V = 768, C_Z = 1024, C_XBC = 1536;
constexpr int NCHUNK = SEQ / 128;
constexpr float LN_EPS = 1e-5f;
constexpr float ALPHA = 1.41421356237309515f;
constexpr float LOG2E = 1.4426950408889634f;

constexpr size_t MiB = 1u << 20;
constexpr size_t WS_STATS = 0;
constexpr size_t WS_DTRAW = 1 * MiB;
constexpr size_t WS_WDT = 2 * MiB;
constexpr size_t WS_POOLW = 2 * MiB + 256 * 1024;
constexpr size_t WS_CDEC = 2 * MiB + 512 * 1024;
constexpr size_t WS_W = 4 * MiB, W_STRIDE = 26 * MiB;
constexpr size_t W_IN = 0, W_OUT = 5 * MiB, W_FF1G = 7 * MiB, W_FF2 = 17 * MiB, W_PLE = 25 * MiB;
constexpr size_t WS_HB = 56 * MiB;
constexpr size_t WS_PB = 120 * MiB;
constexpr size_t WS_FFA = 152 * MiB;
constexpr size_t WS_PROJ = 152 * MiB;
constexpr size_t WS_MIXO = 312 * MiB;
constexpr size_t WS_PG = 408 * MiB;
constexpr size_t WS_STATES = 408 * MiB;
constexpr size_t WS_END = 472 * MiB;
constexpr int LDS_BYTES = 153600;

__device__ __forceinline__ float bf2f(unsigned short u) { return __uint_as_float(((unsigned)u) << 16); }
__device__ __forceinline__ float bflo(unsigned u) { return __uint_as_float(u << 16); }
__device__ __forceinline__ float bfhi(unsigned u) { return __uint_as_float(u & 0xffff0000u); }
__device__ __forceinline__ unsigned pk2(float lo, float hi) { return pg8::cvt_pk_bf16(lo, hi); }
__device__ __forceinline__ float wave_sum(float v) {
#pragma unroll
    for (int o = 1; o < 64; o <<= 1) v += __shfl_xor(v, o);
    return v;
}
__device__ __forceinline__ float fast_sigmoid(float x) { return __builtin_amdgcn_rcpf(1.0f + __builtin_amdgcn_exp2f(-x * LOG2E)); }
__device__ __forceinline__ int crow(int r, int hi) { return (r & 3) + 8 * (r >> 2) + 4 * hi; }

using pg8::Unit;
struct EpiStoreBf16 {
    static constexpr bool PERM = true, AFTER_DRAIN = false;
    bf16_t* O; int ldc;
    __device__ __forceinline__ void operator()(const f32x4 (&acc)[2][2][4][2], const Unit& u, int wr, int wc, int fr, int fq) const {
        const int row0 = u.pm * 256 + wr * 64 + fr, col0 = u.pn * 256 + wc * 32 + 8 * fq;
#pragma unroll
        for (int ai = 0; ai < 2; ++ai)
#pragma unroll
            for (int m = 0; m < 4; ++m) { bf16_t* rowp = O + (size_t)(row0 + ai * 128 + m * 16) * ldc + col0;
#pragma unroll
                for (int bj = 0; bj < 2; ++bj) { const f32x4 v0 = acc[ai][bj][m][0], v1 = acc[ai][bj][m][1];
                    u32x4 w; w.x = pk2(v0[0], v0[1]); w.y = pk2(v0[2], v0[3]); w.z = pk2(v1[0], v1[1]); w.w = pk2(v1[2], v1[3]);
                    *(u32x4*)(rowp + bj * 128) = w; } }
    }
};
struct EpiFf1Gate {
    static constexpr bool PERM = true, AFTER_DRAIN = false;
    bf16_t* FFA; bf16_t* PG;
    __device__ __forceinline__ void operator()(const f32x4 (&acc)[2][2][4][2], const Unit& u, int wr, int wc, int fr, int fq) const {
        const int row0 = u.pm * 256 + wr * 64 + fr;
        if (u.pn < 16) {
            const int col0 = u.pn * 256 + wc * 32 + 8 * fq;
#pragma unroll
            for (int ai = 0; ai < 2; ++ai)
#pragma unroll
                for (int m = 0; m < 4; ++m) { bf16_t* rowp = FFA + (size_t)(row0 + ai * 128 + m * 16) * DFF + col0;
#pragma unroll
                    for (int bj = 0; bj < 2; ++bj) { f32x4 v0 = acc[ai][bj][m][0], v1 = acc[ai][bj][m][1];
#pragma unroll
                        for (int e = 0; e < 4; ++e) { const float a = fmaxf(v0[e], 0.f), b = fmaxf(v1[e], 0.f); v0[e] = a * a; v1[e] = b * b; }
                        u32x4 w; w.x = pk2(v0[0], v0[1]); w.y = pk2(v0[2], v0[3]); w.z = pk2(v1[0], v1[1]); w.w = pk2(v1[2], v1[3]);
                        *(u32x4*)(rowp + bj * 128) = w; } }
        } else {
            const int col0 = (u.pn - 16) * 256 + wc * 32 + 8 * fq;
#pragma unroll
            for (int ai = 0; ai < 2; ++ai)
#pragma unroll
                for (int m = 0; m < 4; ++m) { bf16_t* rowp = PG + (size_t)(row0 + ai * 128 + m * 16) * DM + col0;
#pragma unroll
                    for (int bj = 0; bj < 2; ++bj) { const f32x4 v0 = acc[ai][bj][m][0], v1 = acc[ai][bj][m][1];
                        const u32x4 t = *(const u32x4*)(rowp + bj * 128);
                        u32x4 w;
                        w.x = pk2(bflo(t.x) * fast_sigmoid(v0[0]), bfhi(t.x) * fast_sigmoid(v0[1]));
                        w.y = pk2(bflo(t.y) * fast_sigmoid(v0[2]), bfhi(t.y) * fast_sigmoid(v0[3]));
                        w.z = pk2(bflo(t.z) * fast_sigmoid(v1[0]), bfhi(t.z) * fast_sigmoid(v1[1]));
                        w.w = pk2(bflo(t.w) * fast_sigmoid(v1[2]), bfhi(t.w) * fast_sigmoid(v1[3]));
                        *(u32x4*)(rowp + bj * 128) = w; } }
        }
    }
};
struct EpiResid {
    static constexpr bool PERM = false, AFTER_DRAIN = false;
    const float* src; float* dst; const float* stats; const float* gam; const float* bet; const bf16_t* PG;
    __device__ __forceinline__ void operator()(const f32x4 (&acc)[2][2][4][2], const Unit& u, int wr, int wc, int fr, int fq) const {
        const int row0 = u.pm * 256 + wr * 64 + fr;
        f32x2 st[2][4];
#pragma unroll
        for (int ai = 0; ai < 2; ++ai)
#pragma unroll
            for (int m = 0; m < 4; ++m) st[ai][m] = *(const f32x2*)(stats + 2 * (size_t)(row0 + ai * 128 + m * 16));
#pragma unroll
        for (int bj = 0; bj < 2; ++bj)
#pragma unroll
            for (int n = 0; n < 2; ++n) {
                const int col = u.pn * 256 + bj * 128 + wc * 32 + n * 16 + 4 * fq;
                const f32x4 g4 = *(const f32x4*)(gam + col), b4 = *(const f32x4*)(bet + col);
#pragma unroll
                for (int ai = 0; ai < 2; ++ai)
#pragma unroll
                    for (int m = 0; m < 4; ++m) {
                        const size_t off = (size_t)(row0 + ai * 128 + m * 16) * DM + col;
                        const f32x4 x4 = *(const f32x4*)(src + off);
                        f32x4 o = ((x4 - st[ai][m].x) * st[ai][m].y * g4 + b4) * ALPHA + acc[ai][bj][m][n];
                        if (PG) { const u32x2 t = *(const u32x2*)(PG + off); o[0] += bflo(t.x); o[1] += bfhi(t.x); o[2] += bflo(t.y); o[3] += bfhi(t.y); }
                        *(f32x4*)(dst + off) = o;
                    }
            }
    }
};

struct Args { const float* in[27]; float* out; unsigned char* ws; int ph_lo, ph_hi; };
struct Frame {
    LAS unsigned char* lds; unsigned char* ldsg;
    int tid, lane, wave, G, gw, NGW, bid;
    unsigned char* ws;
};

__device__ __forceinline__ void transpose_item(const float* W, int ldw, int K, int nblk, bf16_t* WT, int row_off, LAS float* scr, int item, int lane) {
    const int kb = item / nblk, nb = item % nblk, k0 = 64 * kb, n0 = 32 * nb;
#pragma unroll 8
    for (int i = 0; i < 32; ++i) { const int kk = 2 * i + (lane >> 5); scr[kk * 33 + (lane & 31)] = W[(size_t)(k0 + kk) * ldw + n0 + (lane & 31)]; }
    asm volatile("s_waitcnt lgkmcnt(0)" ::: "memory");
    const int c = lane & 7;
#pragma unroll
    for (int j = 0; j < 4; ++j) { const int n = (lane >> 3) + 8 * j; const LAS float* s = scr + (8 * c) * 33 + n;
        u32x4 o; o.x = pk2(s[0 * 33], s[1 * 33]); o.y = pk2(s[2 * 33], s[3 * 33]); o.z = pk2(s[4 * 33], s[5 * 33]); o.w = pk2(s[6 * 33], s[7 * 33]);
        *(u32x4*)(WT + (size_t)(row_off + n0 + n) * K + k0 + 8 * c) = o; }
    asm volatile("s_waitcnt lgkmcnt(0)" ::: "memory");
}
template <bool FINAL>
__device__ __forceinline__ void ln_rows(const Frame& F, const float* src, const float* gam, const float* bet, bf16_t* hb, float* stats, const float* wdt, float* dtraw, float* fout) {
    f32x4 g[4], b[4];
#pragma unroll
    for (int j = 0; j < 4; ++j) { g[j] = *(const f32x4*)(gam + 4 * F.lane + 256 * j); b[j] = *(const f32x4*)(bet + 4 * F.lane + 256 * j); }
    for (int row = F.gw; row < MTOK; row += F.NGW) {
        const float* xr = src + (size_t)row * DM + 4 * F.lane;
        f32x4 v[4]; float s = 0.f;
#pragma unroll
        for (int j = 0; j < 4; ++j) { v[j] = *(const f32x4*)(xr + 256 * j); s += (v[j][0] + v[j][1]) + (v[j][2] + v[j][3]); }
        const float mean = wave_sum(s) * (1.f / DM); float s2 = 0.f;
#pragma unroll
        for (int j = 0; j < 4; ++j) { v[j] = v[j] - mean; s2 += (v[j][0] * v[j][0] + v[j][1] * v[j][1]) + (v[j][2] * v[j][2] + v[j][3] * v[j][3]); }
        const float rstd = 1.0f / sqrtf(wave_sum(s2) * (1.f / DM) + LN_EPS);
#pragma unroll
        for (int j = 0; j < 4; ++j) v[j] = v[j] * rstd * g[j] + b[j];
        if (FINAL) {
#pragma unroll
            for (int j = 0; j < 4; ++j) *(f32x4*)(fout + (size_t)row * DM + 4 * F.lane + 256 * j) = v[j];
        } else {
            if (F.lane == 0) *(f32x2*)(stats + 2 * (size_t)row) = (f32x2){mean, rstd};
#pragma unroll
            for (int j = 0; j < 4; ++j) { u32x2 w; w.x = pk2(v[j][0], v[j][1]); w.y = pk2(v[j][2], v[j][3]); *(u32x2*)(hb + (size_t)row * DM + 4 * F.lane + 256 * j) = w; }
            if (wdt) {
                float mine = 0.f;
#pragma unroll
                for (int h = 0; h < 8; ++h) { float d = 0.f;
#pragma unroll
                    for (int j = 0; j < 4; ++j) { const f32x4 w4 = *(const f32x4*)(wdt + h * DM + 4 * F.lane + 256 * j); d += (v[j][0] * w4[0] + v[j][1] * w4[1]) + (v[j][2] * w4[2] + v[j][3] * w4[3]); }
                    d = wave_sum(d); if (F.lane == h) mine = d; }
                if (F.lane < 8) dtraw[(size_t)row * 8 + F.lane] = mine;
            }
        }
    }
}
__device__ __forceinline__ void p0_prologue(const Frame& F, const Args& a) {
    LAS float* scr = (LAS float*)(F.lds + F.wave * 8704);
    unsigned char* ws = F.ws;
    constexpr int I_IN = 16 * 80, I_OUT = 16 * 32, I_FF1 = 16 * 128, I_G = 16 * 32, I_FF2 = 64 * 32, I_PLE = 4 * 32, I_L = I_IN + I_OUT + I_FF1 + I_G + I_FF2 + I_PLE;
    for (int it = F.gw; it < DEPTH * I_L; it += F.NGW) {
        const int l = it / I_L; int r = it % I_L;
        unsigned char* wb = ws + WS_W + (size_t)l * W_STRIDE;
        if (r < I_IN) { transpose_item(a.in[4] + (size_t)l * DM * INW, INW, DM, 80, (bf16_t*)(wb + W_IN), 0, scr, r, F.lane); continue; } r -= I_IN;
        if (r < I_OUT) { transpose_item(a.in[18] + (size_t)l * DM * DM, DM, DM, 32, (bf16_t*)(wb + W_OUT), 0, scr, r, F.lane); continue; } r -= I_OUT;
        if (r < I_FF1) { transpose_item(a.in[21] + (size_t)l * DM * DFF, DFF, DM, 128, (bf16_t*)(wb + W_FF1G), 0, scr, r, F.lane); continue; } r -= I_FF1;
        if (r < I_G) { transpose_item(a.in[24] + (size_t)l * DM * DM, DM, DM, 32, (bf16_t*)(wb + W_FF1G), DFF, scr, r, F.lane); continue; } r -= I_G;
        if (r < I_FF2) { transpose_item(a.in[22] + (size_t)l * DFF * DM, DM, DFF, 32, (bf16_t*)(wb + W_FF2), 0, scr, r, F.lane); continue; } r -= I_FF2;
        transpose_item(a.in[23] + (size_t)l * PLED * DM, DM, PLED, 32, (bf16_t*)(wb + W_PLE), 0, scr, r, F.lane);
    }
    const int gt = F.bid * NTHR + F.tid, NT = F.G * NTHR;
    {
        const float* p = a.in[1]; bf16_t* pb = (bf16_t*)(ws + WS_PB);
        for (size_t i = gt; i < (size_t)DEPTH * MTOK * PLED / 8; i += NT) { const f32x4 x0 = *(const f32x4*)(p + 8 * i), x1 = *(const f32x4*)(p + 8 * i + 4);
            u32x4 w; w.x = pk2(x0[0], x0[1]); w.y = pk2(x0[2], x0[3]); w.z = pk2(x1[0], x1[1]); w.w = pk2(x1[2], x1[3]); *(u32x4*)(pb + 8 * i) = w; }
    }
    {
        float* wdt = (float*)(ws + WS_WDT); bf16_t* pw = (bf16_t*)(ws + WS_POOLW);
        for (int i = gt; i < DEPTH * 8 * DM; i += NT) { const int l = i >> 13, j = (i >> 10) & 7, k = i & 1023; wdt[i] = a.in[4][((size_t)l * DM + k) * INW + NPROJ + j]; }
        for (int i = gt; i < DEPTH * 4 * 64 * 64; i += NT) { const int lg = i >> 12, d = (i >> 6) & 63, c = i & 63; pw[i] = (bf16_t)(pk2(a.in[5][(size_t)lg * 4096 + c * 64 + d], 0.f) & 0xffffu); }
    }
    ln_rows<false>(F, a.in[0], a.in[2], a.in[3], (bf16_t*)(ws + WS_HB), (float*)(ws + WS_STATS), nullptr, nullptr, nullptr);
}
__device__ __forceinline__ void dtraw_from_hb(const Frame& F, const bf16_t* hb, const float* wdt, float* dtraw) {
    for (int row = F.gw; row < MTOK; row += F.NGW) {
        float mine = 0.f; f32x4 v[4];
#pragma unroll
        for (int j = 0; j < 4; ++j) { const u32x2 t = *(const u32x2*)(hb + (size_t)row * DM + 4 * F.lane + 256 * j); v[j] = (f32x4){bflo(t.x), bfhi(t.x), bflo(t.y), bfhi(t.y)}; }
#pragma unroll
        for (int h = 0; h < 8; ++h) { float d = 0.f;
#pragma unroll
            for (int j = 0; j < 4; ++j) { const f32x4 w4 = *(const f32x4*)(wdt + h * DM + 4 * F.lane + 256 * j); d += (v[j][0] * w4[0] + v[j][1] * w4[1]) + (v[j][2] * w4[2] + v[j][3] * w4[3]); }
            d = wave_sum(d); if (F.lane == h) mine = d; }
        if (F.lane < 8) dtraw[(size_t)row * 8 + F.lane] = mine;
    }
}

constexpr int L_TAB_DT = 143360, L_TAB_ACS = 147456, L_TAB_PART = 151552;
constexpr int CPITCH = 136;
__device__ __forceinline__ void ssd_tables(const Frame& F, const float* dtraw, const float* dt_bias, const float* a_log, int row0) {
    LAS float* dtv = (LAS float*)(F.lds + L_TAB_DT); LAS float* acs = (LAS float*)(F.lds + L_TAB_ACS);
    const int hd = F.wave, l0 = 2 * F.lane;
    const float bias = dt_bias[hd], A = -expf(a_log[hd]);
    const float x0 = dtraw[(size_t)(row0 + l0) * 8 + hd] + bias, x1 = dtraw[(size_t)(row0 + l0 + 1) * 8 + hd] + bias;
    const float d0 = fmaxf(x0, 0.f) + log1pf(expf(-fabsf(x0))), d1 = fmaxf(x1, 0.f) + log1pf(expf(-fabsf(x1)));
    const float a0 = d0 * A, a1 = d1 * A;
    float s = a0 + a1;
#pragma unroll
    for (int o = 1; o < 64; o <<= 1) { const float t = __shfl_up(s, o); if (F.lane >= o) s += t; }
    dtv[l0 * 8 + hd] = d0; dtv[(l0 + 1) * 8 + hd] = d1; acs[l0 * 8 + hd] = s - a1; acs[(l0 + 1) * 8 + hd] = s;
}
__device__ __forceinline__ void conv8(const bf16_t* proj, const float* cw, const float* cb, size_t rowbase, int t0, int cch, float (&o0)[8], float (&o1)[8]) {
    float xl[11], xh[11];
#pragma unroll
    for (int i = 0; i < 11; ++i) { const int t = t0 - 3 + i; unsigned v = 0u; if (t >= 0) v = *(const unsigned*)(proj + (rowbase + t) * NPROJ + C_XBC + cch); xl[i] = bflo(v); xh[i] = bfhi(v); }
    float w0[4], w1[4];
#pragma unroll
    for (int k = 0; k < 4; ++k) { const f32x2 w = *(const f32x2*)(cw + k * 1024 + cch); w0[k] = w.x; w1[k] = w.y; }
    const f32x2 bb = *(const f32x2*)(cb + cch);
#pragma unroll
    for (int j = 0; j < 8; ++j) {
        float y0 = bb.x, y1 = bb.y;
#pragma unroll
        for (int k = 0; k < 4; ++k) { y0 += w0[k] * xl[j + k]; y1 += w1[k] * xh[j + k]; }
        o0[j] = y0 * fast_sigmoid(y0); o1[j] = y1 * fast_sigmoid(y1);
    }
}

__device__ __forceinline__ void pool_c1_unit(const Frame& F, const Args& a, int layer, int unit) {
    const int b = unit / NCHUNK, c = unit % NCHUNK; const size_t rowbase = (size_t)b * SEQ; const int tc0 = c * 128;
    const bf16_t* proj = (const bf16_t*)(F.ws + WS_PROJ); bf16_t* mixo = (bf16_t*)(F.ws + WS_MIXO);
    const int tid = F.tid, lane = F.lane, wid = F.wave, r32 = lane & 31, hi = lane >> 5;
    {
        constexpr int PP = 264;
        LAS bf16_t* Pl = (LAS bf16_t*)F.lds;
        const int cp = tid & 127, sg = tid >> 7, gi = cp >> 5, w = 2 << gi;
        const bf16_t* up = proj + rowbase * NPROJ + C_POOL + 2 * cp;
        const int t0 = tc0 + sg * 32;
        float s0 = 0.f, s1 = 0.f;
        for (int i = 1; i < w; ++i) { const int t = t0 - i; if (t >= 0) { const unsigned v = *(const unsigned*)(up + (size_t)t * NPROJ); s0 += bflo(v); s1 += bfhi(v); } }
        for (int j = 0; j < 32; ++j) {
            const int t = t0 + j; const unsigned v = *(const unsigned*)(up + (size_t)t * NPROJ); const float u0 = bflo(v), u1 = bfhi(v);
            s0 += u0; s1 += u1;
            const float inv = 1.0f / (float)min(t + 1, w);
            *(LAS unsigned*)(Pl + (sg * 32 + j) * PP + 2 * cp) = pk2(s0 * inv - u0, s1 * inv - u1);
            const int tl = t - w + 1; if (tl >= 0) { const unsigned q = *(const unsigned*)(up + (size_t)tl * NPROJ); s0 -= bflo(q); s1 -= bfhi(q); }
        }
        __syncthreads();
        const int gw4 = wid >> 1, dt = wid & 1;
        const bf16_t* pw = (const bf16_t*)(F.ws + WS_POOLW) + ((size_t)(layer * 4 + gw4) * 64 + dt * 32 + r32) * 64;
        bf16x8 bfr[4];
#pragma unroll
        for (int ks = 0; ks < 4; ++ks) bfr[ks] = *(const bf16x8*)(pw + ks * 16 + hi * 8);
        const float sc = a.in[6][layer * 256 + gw4 * 64 + dt * 32 + r32];
#pragma unroll
        for (int tt = 0; tt < 4; ++tt) {
            f32x16 acc = {};
#pragma unroll
            for (int ks = 0; ks < 4; ++ks) { const bf16x8 af = *(const LAS bf16x8*)(Pl + (tt * 32 + r32) * PP + gw4 * 64 + ks * 16 + hi * 8); acc = MFMA32(af, bfr[ks], acc); }
            bf16_t* op = mixo + (rowbase + tc0 + tt * 32) * DM + C_POOL + gw4 * 64 + dt * 32 + r32;
#pragma unroll
            for (int j = 0; j < 16; ++j) op[(size_t)crow(j, hi) * DM] = (bf16_t)(pk2(acc[j] * sc, 0.f) & 0xffffu);
        }
        __syncthreads();
    }
    const float* dtraw = (const float*)(F.ws + WS_DTRAW);
    ssd_tables(F, dtraw, a.in[14] + layer * 8, a.in[15] + layer * 8, (int)rowbase + tc0);
    __syncthreads();
    LAS float* dtv = (LAS float*)(F.lds + L_TAB_DT); LAS float* acs = (LAS float*)(F.lds + L_TAB_ACS);
    const float* cw = a.in[12] + (size_t)layer * 4 * 1024; const float* cb = a.in[13] + (size_t)layer * 1024;
    LAS bf16_t* XS = (LAS bf16_t*)F.lds;
    LAS bf16_t* BT = (LAS bf16_t*)(F.lds + 256 * CPITCH * 2);
    float* states = (float*)(F.ws + WS_STATES);
    if (tid < 8) ((float*)(F.ws + WS_CDEC))[(size_t)unit * 8 + tid] = expf(acs[127 * 8 + tid]);
    for (int g = 0; g < 2; ++g) {
        for (int it = tid; it < 192 * 16; it += NTHR) {
            const int cpi = it % 192, oct = it / 192;
            const bool isx = cpi < 128;
            const int chl = isx ? 2 * cpi : 2 * (cpi - 128);
            const int cch = isx ? g * 256 + chl : 512 + g * 128 + chl;
            float o0[8], o1[8];
            conv8(proj, cw, cb, rowbase, tc0 + oct * 8, cch, o0, o1);
            if (isx) { const int hd = g * 4 + (chl >> 6); const float al = acs[127 * 8 + hd];
#pragma unroll
                for (int j = 0; j < 8; ++j) { const int l = oct * 8 + j; const float sc = dtv[l * 8 + hd] * __builtin_amdgcn_exp2f((al - acs[l * 8 + hd]) * LOG2E); o0[j] *= sc; o1[j] *= sc; } }
            LAS bf16_t* dst = (isx ? XS : BT) + chl * CPITCH + oct * 8;
            u32x4 w0, w1;
            w0.x = pk2(o0[0], o0[1]); w0.y = pk2(o0[2], o0[3]); w0.z = pk2(o0[4], o0[5]); w0.w = pk2(o0[6], o0[7]);
            w1.x = pk2(o1[0], o1[1]); w1.y = pk2(o1[2], o1[3]); w1.z = pk2(o1[4], o1[5]); w1.w = pk2(o1[6], o1[7]);
            *(LAS u32x4*)dst = w0; *(LAS u32x4*)(dst + CPITCH) = w1;
        }
        __syncthreads();
        {
            const int r = wid >> 1, pt = wid & 1;
            f32x16 acc[4] = {};
#pragma unroll
            for (int ks = 0; ks < 8; ++ks) {
                const bf16x8 af = *(const LAS bf16x8*)(XS + (r * 64 + pt * 32 + r32) * CPITCH + ks * 16 + hi * 8);
#pragma unroll
                for (int nt = 0; nt < 4; ++nt) { const bf16x8 bf = *(const LAS bf16x8*)(BT + (nt * 32 + r32) * CPITCH + ks * 16 + hi * 8); acc[nt] = MFMA32(af, bf, acc[nt]); }
            }
            float* sp = states + ((size_t)unit * 8 + g * 4 + r) * 8192;
#pragma unroll
            for (int nt = 0; nt < 4; ++nt)
#pragma unroll
                for (int j = 0; j < 16; ++j) sp[(pt * 32 + crow(j, hi)) * 128 + nt * 32 + r32] = acc[nt][j];
        }
        __syncthreads();
    }
}

__device__ __forceinline__ void scan_phase(const Frame& F) {
    float* states = (float*)(F.ws + WS_STATES); const float* cdec = (const float*)(F.ws + WS_CDEC);
    const int gt = F.bid * NTHR + F.tid, NT = F.G * NTHR;
    for (int idx = gt; idx < BATCH * 8 * 8192; idx += NT) {
        const int b = idx >> 16, hd = (idx >> 13) & 7, e = idx & 8191;
        float h = 0.f;
        for (int c0 = 0; c0 < NCHUNK; c0 += 8) {
            float st[8], dc[8];
#pragma unroll
            for (int i = 0; i < 8; ++i) { const size_t ch = (size_t)(b * NCHUNK + c0 + i) * 8 + hd; st[i] = states[ch * 8192 + e]; dc[i] = cdec[ch]; }
#pragma unroll
            for (int i = 0; i < 8; ++i) { const size_t ch = (size_t)(b * NCHUNK + c0 + i) * 8 + hd; states[ch * 8192 + e] = h; h = h * dc[i] + st[i]; }
        }
    }
}

__device__ __forceinline__ void c3_unit(const Frame& F, const Args& a, int layer, int unit) {
    const int b = unit / NCHUNK, c = unit % NCHUNK; const size_t rowbase = (size_t)b * SEQ; const int tc0 = c * 128;
    const bf16_t* proj = (const bf16_t*)(F.ws + WS_PROJ); bf16_t* mixo = (bf16_t*)(F.ws + WS_MIXO);
    const int tid = F.tid, lane = F.lane, wid = F.wave, r32 = lane & 31, hi = lane >> 5;
    const float* dtraw = (const float*)(F.ws + WS_DTRAW);
    __syncthreads();
    ssd_tables(F, dtraw, a.in[14] + layer * 8, a.in[15] + layer * 8, (int)rowbase + tc0);
    LAS float* dtv = (LAS float*)(F.lds + L_TAB_DT); LAS float* acs = (LAS float*)(F.lds + L_TAB_ACS); LAS float* part = (LAS float*)(F.lds + L_TAB_PART);
    const float* cw = a.in[12] + (size_t)layer * 4 * 1024; const float* cb = a.in[13] + (size_t)layer * 1024;
    LAS bf16_t* XS = (LAS bf16_t*)F.lds;
    LAS bf16_t* BM = (LAS bf16_t*)(F.lds + 256 * CPITCH * 2);
    LAS bf16_t* CM = (LAS bf16_t*)(F.lds + 384 * CPITCH * 2);
    const float* states = (const float*)(F.ws + WS_STATES);
    const int lt = wid & 3, hp = wid >> 2, l = lt * 32 + r32;
    for (int g = 0; g < 2; ++g) {
        for (int it = tid; it < 256 * 16; it += NTHR) {
            const int cpi = it & 255, oct = it >> 8;
            const int sec = cpi < 128 ? 0 : (cpi < 192 ? 1 : 2);
            const int chl = sec == 0 ? 2 * cpi : (sec == 1 ? 2 * (cpi - 128) : 2 * (cpi - 192));
            const int cch = sec == 0 ? g * 256 + chl : (sec == 1 ? 512 + g * 128 + chl : 768 + g * 128 + chl);
            float o0[8], o1[8];
            conv8(proj, cw, cb, rowbase, tc0 + oct * 8, cch, o0, o1);
            if (sec == 0) {
                LAS bf16_t* dst = XS + chl * CPITCH + oct * 8; u32x4 w0, w1;
                w0.x = pk2(o0[0], o0[1]); w0.y = pk2(o0[2], o0[3]); w0.z = pk2(o0[4], o0[5]); w0.w = pk2(o0[6], o0[7]);
                w1.x = pk2(o1[0], o1[1]); w1.y = pk2(o1[2], o1[3]); w1.z = pk2(o1[4], o1[5]); w1.w = pk2(o1[6], o1[7]);
                *(LAS u32x4*)dst = w0; *(LAS u32x4*)(dst + CPITCH) = w1;
            } else {
                LAS bf16_t* dst = (sec == 1 ? BM : CM) + (oct * 8) * CPITCH + chl;
#pragma unroll
                for (int j = 0; j < 8; ++j) *(LAS unsigned*)(dst + j * CPITCH) = pk2(o0[j], o1[j]);
            }
        }
        __syncthreads();
        f32x16 acc[2][2];
#pragma unroll
        for (int hh = 0; hh < 2; ++hh) {
            const int hd = g * 4 + hp * 2 + hh;
            const float* pv = states + ((size_t)unit * 8 + hd) * 8192;
#pragma unroll
            for (int pt = 0; pt < 2; ++pt) acc[hh][pt] = (f32x16){};
#pragma unroll
            for (int ks = 0; ks < 8; ++ks) {
                const bf16x8 cf = *(const LAS bf16x8*)(CM + l * CPITCH + ks * 16 + hi * 8);
#pragma unroll
                for (int pt = 0; pt < 2; ++pt) {
                    const float* pp = pv + (pt * 32 + r32) * 128 + ks * 16 + hi * 8;
                    const f32x4 p0 = *(const f32x4*)pp, p1 = *(const f32x4*)(pp + 4);
                    u32x4 w; w.x = pk2(p0[0], p0[1]); w.y = pk2(p0[2], p0[3]); w.z = pk2(p1[0], p1[1]); w.w = pk2(p1[2], p1[3]);
                    acc[hh][pt] = MFMA32(__builtin_bit_cast(bf16x8, w), cf, acc[hh][pt]);
                }
            }
            const float ea = __builtin_amdgcn_exp2f(acs[l * 8 + hd] * LOG2E);
#pragma unroll
            for (int pt = 0; pt < 2; ++pt)
#pragma unroll
                for (int j = 0; j < 16; ++j) acc[hh][pt][j] *= ea;
        }
        for (int st = 0; st <= lt; ++st) {
            f32x16 cbt = {};
#pragma unroll
            for (int ks = 0; ks < 8; ++ks) {
                const bf16x8 bf = *(const LAS bf16x8*)(BM + (st * 32 + r32) * CPITCH + ks * 16 + hi * 8);
                const bf16x8 cf = *(const LAS bf16x8*)(CM + l * CPITCH + ks * 16 + hi * 8);
                cbt = MFMA32(bf, cf, cbt);
            }
#pragma unroll
            for (int hh = 0; hh < 2; ++hh) {
                const int hd = g * 4 + hp * 2 + hh;
                const float al = acs[l * 8 + hd], dsk = a.in[16][layer * 8 + hd];
                float x[16];
#pragma unroll
                for (int j = 0; j < 16; ++j) { const int s = st * 32 + crow(j, hi);
                    const float e = __builtin_amdgcn_exp2f(fminf(al - acs[s * 8 + hd], 0.f) * LOG2E) * dtv[s * 8 + hd];
                    x[j] = (s <= l) ? cbt[j] * e : 0.f; if (s == l) x[j] += dsk; }
                u32x4 w0, w1;
                w0.x = pk2(x[0], x[1]); w0.y = pk2(x[2], x[3]); w0.z = pk2(x[4], x[5]); w0.w = pk2(x[6], x[7]);
                w1.x = pk2(x[8], x[9]); w1.y = pk2(x[10], x[11]); w1.z = pk2(x[12], x[13]); w1.w = pk2(x[14], x[15]);
                const bf16x8 xf0 = __builtin_bit_cast(bf16x8, w0), xf1 = __builtin_bit_cast(bf16x8, w1);
#pragma unroll
                for (int pt = 0; pt < 2; ++pt) {
                    const LAS bf16_t* xr = XS + ((hp * 2 + hh) * 64 + pt * 32 + r32) * CPITCH + st * 32 + 4 * hi;
                    const u32x2 a0 = *(const LAS u32x2*)(xr), a1 = *(const LAS u32x2*)(xr + 8), a2 = *(const LAS u32x2*)(xr + 16), a3 = *(const LAS u32x2*)(xr + 24);
                    const u32x4 f0 = {a0.x, a0.y, a1.x, a1.y}, f1 = {a2.x, a2.y, a3.x, a3.y};
                    acc[hh][pt] = MFMA32(__builtin_bit_cast(bf16x8, f0), xf0, acc[hh][pt]);
                    acc[hh][pt] = MFMA32(__builtin_bit_cast(bf16x8, f1), xf1, acc[hh][pt]);
                }
            }
        }
        float ssq = 0.f;
        const size_t orow = (rowbase + tc0 + l);
#pragma unroll
        for (int hh = 0; hh < 2; ++hh)
#pragma unroll
            for (int pt = 0; pt < 2; ++pt)
#pragma unroll
                for (int q = 0; q < 4; ++q) {
                    const int ch = g * 256 + (hp * 2 + hh) * 64 + pt * 32 + 8 * q + 4 * hi;
                    const u32x2 zz = *(const u32x2*)(proj + orow * NPROJ + C_Z + ch);
                    const float z0 = bflo(zz.x), z1 = bfhi(zz.x), z2 = bflo(zz.y), z3 = bfhi(zz.y);
                    const float y0 = acc[hh][pt][4 * q + 0] * z0 * fast_sigmoid(z0), y1 = acc[hh][pt][4 * q + 1] * z1 * fast_sigmoid(z1);
                    const float y2 = acc[hh][pt][4 * q + 2] * z2 * fast_sigmoid(z2), y3 = acc[hh][pt][4 * q + 3] * z3 * fast_sigmoid(z3);
                    ssq += (y0 * y0 + y1 * y1) + (y2 * y2 + y3 * y3);
                    u32x2 w; w.x = pk2(y0, y1); w.y = pk2(y2, y3);
                    *(u32x2*)(mixo + orow * DM + 512 + ch) = w;
                }
        ssq += __shfl_xor(ssq, 32);
        if (hi == 0) part[l * 4 + g * 2 + hp] = ssq;
        __syncthreads();
    }
    {
        const float* ng = a.in[17] + layer * 512;
        for (int it = tid; it < 128 * 64; it += NTHR) {
            const int row = it >> 6, cc = (it & 63) * 8;
            const float ss = (part[row * 4 + 0] + part[row * 4 + 1]) + (part[row * 4 + 2] + part[row * 4 + 3]);
            const float rinv = 1.0f / sqrtf(ss * (1.0f / 512.0f) + LN_EPS);
            bf16_t* p = mixo + (rowbase + tc0 + row) * DM + 512 + cc;
            const u32x4 t = *(const u32x4*)p; const f32x4 g0 = *(const f32x4*)(ng + cc), g1 = *(const f32x4*)(ng + cc + 4);
            u32x4 w;
            w.x = pk2(bflo(t.x) * rinv * g0[0], bfhi(t.x) * rinv * g0[1]); w.y = pk2(bflo(t.y) * rinv * g0[2], bfhi(t.y) * rinv * g0[3]);
            w.z = pk2(bflo(t.z) * rinv * g1[0], bfhi(t.z) * rinv * g1[1]); w.w = pk2(bflo(t.w) * rinv * g1[2], bfhi(t.w) * rinv * g1[3]);
            *(u32x4*)p = w;
        }
    }
    __syncthreads();
}

constexpr int KP = 72;
constexpr int L_KBUF = 0, L_VBUF = 2 * 64 * KP * 2;
__device__ __forceinline__ void attn_unit(const Frame& F, const Args& a, int layer, int b, int h, int qb) {
    const bf16_t* proj = (const bf16_t*)(F.ws + WS_PROJ); bf16_t* mixo = (bf16_t*)(F.ws + WS_MIXO);
    const int tid = F.tid, lane = F.lane, wid = F.wave, r32 = lane & 31, hi = lane >> 5;
    const size_t rowbase = (size_t)b * SEQ; const int q0 = qb * 256, qw0 = q0 + wid * 32, myq = qw0 + r32;
    LAS bf16_t* Kb = (LAS bf16_t*)(F.lds + L_KBUF); LAS bf16_t* Vb = (LAS bf16_t*)(F.lds + L_VBUF);
    bf16x8 qf[2][2];
    { const bf16_t* qp = proj + (rowbase + myq) * NPROJ + C_Q + h * 64 + hi * 8;
#pragma unroll
      for (int j = 0; j < 2; ++j)
#pragma unroll
        for (int ks = 0; ks < 2; ++ks) qf[j][ks] = *(const bf16x8*)(qp + j * 32 + ks * 16); }
    const float csc = 0.17677669529663687f * LOG2E;
    f32x16 o1[2], o2[2];
#pragma unroll
    for (int v = 0; v < 2; ++v) { o1[v] = (f32x16){}; o2[v] = (f32x16){}; }
    float m1 = -INFINITY, m2 = -INFINITY, l1 = 0.f, l2 = 0.f;
    const int NT = (q0 + 256) / 64;
    const bf16_t* kg = proj + (rowbase + (tid >> 3)) * NPROJ + C_K + h * 64 + (tid & 7) * 8;
    const bf16_t* vg = proj + (rowbase + lane) * NPROJ + C_V + h * 64 + wid * 8;
    LAS bf16_t* kdst = Kb + (tid >> 3) * KP + (tid & 7) * 8;
    LAS bf16_t* vdst = Vb + (wid * 8) * KP + lane;
    u32x4 kreg = *(const u32x4*)kg, vreg = *(const u32x4*)vg;
    __syncthreads();
    {
        *(LAS u32x4*)kdst = kreg;
        vdst[0 * KP] = (bf16_t)(vreg.x & 0xffffu); vdst[1 * KP] = (bf16_t)(vreg.x >> 16); vdst[2 * KP] = (bf16_t)(vreg.y & 0xffffu); vdst[3 * KP] = (bf16_t)(vreg.y >> 16);
        vdst[4 * KP] = (bf16_t)(vreg.z & 0xffffu); vdst[5 * KP] = (bf16_t)(vreg.z >> 16); vdst[6 * KP] = (bf16_t)(vreg.w & 0xffffu); vdst[7 * KP] = (bf16_t)(vreg.w >> 16);
    }
    __syncthreads();
    for (int t = 0; t < NT; ++t) {
        const int buf = t & 1;
        if (t + 1 < NT) { kreg = *(const u32x4*)(kg + (size_t)(t + 1) * 64 * NPROJ); vreg = *(const u32x4*)(vg + (size_t)(t + 1) * 64 * NPROJ); }
        const LAS bf16_t* Kt = Kb + buf * 64 * KP; const LAS bf16_t* Vt = Vb + buf * 64 * KP;
#pragma unroll
        for (int kb = 0; kb < 2; ++kb) {
            const int kbase = t * 64 + kb * 32;
            if (kbase <= qw0 + 31) {
                f32x16 s1 = {}, s2 = {};
#pragma unroll
                for (int ks = 0; ks < 2; ++ks) {
                    const bf16x8 k1 = *(const LAS bf16x8*)(Kt + (kb * 32 + r32) * KP + ks * 16 + hi * 8);
                    const bf16x8 k2 = *(const LAS bf16x8*)(Kt + (kb * 32 + r32) * KP + 32 + ks * 16 + hi * 8);
                    s1 = MFMA32(k1, qf[0][ks], s1); s2 = MFMA32(k2, qf[1][ks], s2);
                }
                if (kbase + 31 > qw0) {
#pragma unroll
                    for (int j = 0; j < 16; ++j) { const int key = kbase + crow(j, hi); if (key > myq) { s1[j] = -INFINITY; s2[j] = -INFINITY; } }
                }
                float mx1 = s1[0], mx2 = s2[0];
#pragma unroll
                for (int j = 1; j < 16; ++j) { mx1 = fmaxf(mx1, s1[j]); mx2 = fmaxf(mx2, s2[j]); }
                mx1 = fmaxf(mx1, __shfl_xor(mx1, 32)); mx2 = fmaxf(mx2, __shfl_xor(mx2, 32));
                const float mn1 = fmaxf(m1, mx1 * csc), mn2 = fmaxf(m2, mx2 * csc);
                const float al1 = __builtin_amdgcn_exp2f(m1 - mn1), al2 = __builtin_amdgcn_exp2f(m2 - mn2);
                m1 = mn1; m2 = mn2;
                float ps1 = 0.f, ps2 = 0.f;
#pragma unroll
                for (int j = 0; j < 16; ++j) { s1[j] = __builtin_amdgcn_exp2f(s1[j] * csc - mn1); s2[j] = __builtin_amdgcn_exp2f(s2[j] * csc - mn2); ps1 += s1[j]; ps2 += s2[j]; }
                l1 = l1 * al1 + ps1; l2 = l2 * al2 + ps2;
#pragma unroll
                for (int v = 0; v < 2; ++v)
#pragma unroll
                    for (int j = 0; j < 16; ++j) { o1[v][j] *= al1; o2[v][j] *= al2; }
                bf16x8 p1[2], p2[2];
#pragma unroll
                for (int ks = 0; ks < 2; ++ks) {
                    u32x4 w; w.x = pk2(s1[8 * ks + 0], s1[8 * ks + 1]); w.y = pk2(s1[8 * ks + 2], s1[8 * ks + 3]); w.z = pk2(s1[8 * ks + 4], s1[8 * ks + 5]); w.w = pk2(s1[8 * ks + 6], s1[8 * ks + 7]);
                    p1[ks] = __builtin_bit_cast(bf16x8, w);
                    u32x4 y; y.x = pk2(s2[8 * ks + 0], s2[8 * ks + 1]); y.y = pk2(s2[8 * ks + 2], s2[8 * ks + 3]); y.z = pk2(s2[8 * ks + 4], s2[8 * ks + 5]); y.w = pk2(s2[8 * ks + 6], s2[8 * ks + 7]);
                    p2[ks] = __builtin_bit_cast(bf16x8, y);
                }
#pragma unroll
                for (int v = 0; v < 2; ++v)
#pragma unroll
                    for (int ks = 0; ks < 2; ++ks) {
                        const LAS bf16_t* vp = Vt + (v * 32 + r32) * KP + kb * 32 + ks * 16 + 4 * hi;
                        const u32x2 a0 = *(const LAS u32x2*)vp, a1 = *(const LAS u32x2*)(vp + 8);
                        const u32x4 f = {a0.x, a0.y, a1.x, a1.y}; const bf16x8 vf = __builtin_bit_cast(bf16x8, f);
                        o1[v] = MFMA32(vf, p1[ks], o1[v]); o2[v] = MFMA32(vf, p2[ks], o2[v]);
                    }
            }
        }
        if (t + 1 < NT) {
            LAS bf16_t* kd = kdst + (buf ^ 1) * 64 * KP; LAS bf16_t* vd = vdst + (buf ^ 1) * 64 * KP;
            *(LAS u32x4*)kd = kreg;
            vd[0 * KP] = (bf16_t)(vreg.x & 0xffffu); vd[1 * KP] = (bf16_t)(vreg.x >> 16); vd[2 * KP] = (bf16_t)(vreg.y & 0xffffu); vd[3 * KP] = (bf16_t)(vreg.y >> 16);
            vd[4 * KP] = (bf16_t)(vreg.z & 0xffffu); vd[5 * KP] = (bf16_t)(vreg.z >> 16); vd[6 * KP] = (bf16_t)(vreg.w & 0xffffu); vd[7 * KP] = (bf16_t)(vreg.w >> 16);
        }
        __syncthreads();
    }
    float d1 = 0.f, d2 = 0.f;
#pragma unroll 8
    for (int i = 0; i < 32; ++i) { d1 += a.in[7][layer * 32 + i] * a.in[8][layer * 32 + i]; d2 += a.in[9][layer * 32 + i] * a.in[10][layer * 32 + i]; }
    const float lam_init = 0.8f - 0.6f * expf(-0.3f * (float)layer);
    const float lam = expf(d1) - expf(d2) + lam_init;
    l1 += __shfl_xor(l1, 32); l2 += __shfl_xor(l2, 32);
    const float i1 = 1.0f / l1, i2 = lam / l2;
    float ssq = 0.f;
#pragma unroll
    for (int v = 0; v < 2; ++v)
#pragma unroll
        for (int j = 0; j < 16; ++j) { const float o = o1[v][j] * i1 - o2[v][j] * i2; o1[v][j] = o; ssq += o * o; }
    ssq += __shfl_xor(ssq, 32);
    const float sc = (1.0f - lam_init) / sqrtf(ssq * (1.0f / 64.0f) + LN_EPS);
    const float* ng = a.in[11] + layer * 64;
    bf16_t* op = mixo + (rowbase + myq) * DM + 256 + h * 64;
#pragma unroll
    for (int v = 0; v < 2; ++v)
#pragma unroll
        for (int q = 0; q < 4; ++q) {
            const int vd = v * 32 + 8 * q + 4 * hi; const f32x4 g4 = *(const f32x4*)(ng + vd);
            u32x2 w; w.x = pk2(o1[v][4 * q + 0] * sc * g4[0], o1[v][4 * q + 1] * sc * g4[1]); w.y = pk2(o1[v][4 * q + 2] * sc * g4[2], o1[v][4 * q + 3] * sc * g4[3]);
            *(u32x2*)(op + vd) = w;
        }
}

#ifndef MK_SPLIT
#define MK_SPLIT 0
#endif
constexpr int NPHASE = 1 + 9 * DEPTH;
__global__ void __launch_bounds__(NTHR, 2) fwd_megakernel(Args a) {
    extern __shared__ __attribute__((aligned(16))) unsigned char lds[];
    cg::grid_group grid = cg::this_grid();
    Frame F;
    F.lds = (LAS unsigned char*)lds; F.ldsg = lds;
    F.tid = threadIdx.x; F.lane = F.tid & 63; F.wave = __builtin_amdgcn_readfirstlane(F.tid >> 6);
    F.G = gridDim.x; F.gw = blockIdx.x * NWAVES + F.wave; F.NGW = F.G * NWAVES; F.ws = a.ws;
    int vcu = (F.G % 8 == 0) ? ((int)blockIdx.x % 8) * (F.G / 8) + (int)blockIdx.x / 8 : (int)blockIdx.x;
    unsigned char* ws = a.ws;
    bf16_t* HB = (bf16_t*)(ws + WS_HB); bf16_t* PROJ = (bf16_t*)(ws + WS_PROJ); bf16_t* MIXO = (bf16_t*)(ws + WS_MIXO);
    bf16_t* FFA = (bf16_t*)(ws + WS_FFA); bf16_t* PG = (bf16_t*)(ws + WS_PG);
    float* STATS = (float*)(ws + WS_STATS); float* DTRAW = (float*)(ws + WS_DTRAW); const float* WDT = (const float*)(ws + WS_WDT);
#ifndef PHMASK
#define PHMASK 0x3ff
#endif
#define IN(k) (a.ph_lo <= (k) && (k) < a.ph_hi)
#define EN(i) ((PHMASK >> (i)) & 1)
#define FRESH() do { int t_ = threadIdx.x, b_ = blockIdx.x; asm volatile("" : "+v"(t_)); asm volatile("" : "+s"(b_)); F.tid = t_; F.lane = t_ & 63; F.wave = __builtin_amdgcn_readfirstlane(t_ >> 6); F.bid = b_; F.gw = b_ * NWAVES + F.wave; \
        vcu = (F.G % 8 == 0) ? (b_ % 8) * (F.G / 8) + b_ / 8 : b_; } while (0)
#define SEAM(k) do { if (IN(k) && IN((k) + 1)) grid.sync(); } while (0)
    if (EN(0) && IN(0)) { FRESH(); p0_prologue(F, a); }
    SEAM(0);
    for (int layer = 0; layer < DEPTH; ++layer) {
        const int pb = 1 + 9 * layer;
        const unsigned char* wb = ws + WS_W + (size_t)layer * W_STRIDE;
        if (EN(1) && IN(pb + 0)) { FRESH();
            if (layer == 0) { dtraw_from_hb(F, HB, WDT, DTRAW); FRESH(); }
            pg8::Gemm g{HB, (const bf16_t*)(wb + W_IN), MTOK, NPROJ, DM}; pg8::StaticOrder S; S.init(MTOK, NPROJ, F.G, F.bid);
            EpiStoreBf16 E{PROJ, NPROJ};
            pg8::gemm_phase<EpiStoreBf16, pg8::StaticOrder, true, true>(F.lds, g, S, E, F.tid);
        }
        SEAM(pb + 0);
        if (EN(2) && IN(pb + 1)) { FRESH(); for (int u = F.bid; u < BATCH * NCHUNK; u += F.G) pool_c1_unit(F, a, layer, u); }
        SEAM(pb + 1);
        if (EN(3) && IN(pb + 2)) { FRESH(); scan_phase(F); }
        SEAM(pb + 2);
        if (EN(4) && IN(pb + 3)) { FRESH();
            for (int v = vcu; v < 256; v += F.G) { const int bh = v >> 4, s = v & 15;
                attn_unit(F, a, layer, bh >> 2, bh & 3, 31 - s);
                attn_unit(F, a, layer, bh >> 2, bh & 3, s); }
            FRESH(); for (int u = F.bid; u < BATCH * NCHUNK; u += F.G) c3_unit(F, a, layer, u);
        }
        SEAM(pb + 3);
        if (EN(5) && IN(pb + 4)) { FRESH();
            { pg8::Gemm g{MIXO, (const bf16_t*)(wb + W_OUT), MTOK, DM, DM}; pg8::StaticOrder S; S.init(MTOK, DM, F.G, F.bid);
              EpiResid E{layer == 0 ? a.in[0] : (const float*)a.out, a.out, STATS, layer == 0 ? a.in[2] : a.in[25], layer == 0 ? a.in[3] : a.in[26], nullptr};
              pg8::gemm_phase<EpiResid, pg8::StaticOrder, true, true>(F.lds, g, S, E, F.tid); }
            FRESH();
            { pg8::Gemm g{(const bf16_t*)(ws + WS_PB) + (size_t)layer * MTOK * PLED, (const bf16_t*)(wb + W_PLE), MTOK, DM, PLED}; pg8::StaticOrder S; S.init(MTOK, DM, F.G, F.bid);
              EpiStoreBf16 E{PG, DM};
              pg8::gemm_phase<EpiStoreBf16, pg8::StaticOrder, true, true>(F.lds, g, S, E, F.tid); }
        }
        SEAM(pb + 4);
        if (EN(6) && IN(pb + 5)) { FRESH(); ln_rows<false>(F, a.out, a.in[19] + layer * DM, a.in[20] + layer * DM, HB, STATS, nullptr, nullptr, nullptr); }
        SEAM(pb + 5);
        if (EN(7) && IN(pb + 6)) { FRESH();
            pg8::Gemm g{HB, (const bf16_t*)(wb + W_FF1G), MTOK, DFF + DM, DM}; pg8::StaticOrder S; S.init(MTOK, DFF + DM, F.G, F.bid);
            EpiFf1Gate E{FFA, PG};
            pg8::gemm_phase<EpiFf1Gate, pg8::StaticOrder, true, true>(F.lds, g, S, E, F.tid);
        }
        SEAM(pb + 6);
        if (EN(8) && IN(pb + 7)) { FRESH();
            pg8::Gemm g{FFA, (const bf16_t*)(wb + W_FF2), MTOK, DM, DFF}; pg8::StaticOrder S; S.init(MTOK, DM, F.G, F.bid);
            EpiResid E{(const float*)a.out, a.out, STATS, a.in[19] + layer * DM, a.in[20] + layer * DM, PG};
            pg8::gemm_phase<EpiResid, pg8::StaticOrder, true, true>(F.lds, g, S, E, F.tid);
        }
        SEAM(pb + 7);
        if (EN(9) && IN(pb + 8)) { FRESH();
            if (layer + 1 < DEPTH) ln_rows<false>(F, a.out, a.in[25] + layer * DM, a.in[26] + layer * DM, HB, STATS, WDT + (size_t)(layer + 1) * 8 * DM, DTRAW, nullptr);
            else ln_rows<true>(F, a.out, a.in[25] + layer * DM, a.in[26] + layer * DM, nullptr, nullptr, nullptr, nullptr, a.out);
        }
        if (layer + 1 < DEPTH) SEAM(pb + 8);
    }
#undef IN
#undef SEAM
}

extern "C" void kernel_launch(void* const* d_in, const int* in_sizes, int n_in, void* d_out, int out_size, void* d_ws, size_t ws_size, hipStream_t stream) {
    static int grid = 0;
    if (grid == 0) {
        if (n_in != 27 || out_size != MTOK * DM || ws_size < WS_END) { fprintf(stderr, "kernel_launch: unexpected shapes (n_in %d out %d ws %zu)\n", n_in, out_size, ws_size); grid = -1; return; }
        int dev = 0, cus = 0, per_cu = 0;
        (void)hipGetDevice(&dev); (void)hipDeviceGetAttribute(&cus, hipDeviceAttributeMultiprocessorCount, dev);
        if (hipFuncSetAttribute((const void*)fwd_megakernel, hipFuncAttributeMaxDynamicSharedMemorySize, LDS_BYTES) != hipSuccess) { fprintf(stderr, "kernel_launch: hipFuncSetAttribute failed\n"); grid = -1; return; }
        if (hipOccupancyMaxActiveBlocksPerMultiprocessor(&per_cu, (const void*)fwd_megakernel, NTHR, LDS_BYTES) != hipSuccess || per_cu < 1) per_cu = 1;
        (void)hipGetLastError();
        grid = cus * per_cu; if (grid > 256) grid = 256; if (grid < 1) grid = 1;
    }
    if (grid < 0) return;
    Args a{};
    for (int i = 0; i < 27; ++i) a.in[i] = (const float*)d_in[i];
    a.out = (float*)d_out; a.ws = (unsigned char*)d_ws;
#if MK_SPLIT
    for (int ph = 0; ph < NPHASE; ++ph) { a.ph_lo = ph; a.ph_hi = ph + 1; void* args[] = {&a};
        hipError_t e = hipLaunchCooperativeKernel((const void*)fwd_megakernel, dim3(grid), dim3(NTHR), args, LDS_BYTES, stream);
        if (e != hipSuccess) { fprintf(stderr, "launch %d failed: %s\n", ph, hipGetErrorString(e)); break; } }
#else
    a.ph_lo = 0; a.ph_hi = NPHASE; void* args[] = {&a};
    hipError_t e = hipLaunchCooperativeKernel((const void*)fwd_megakernel, dim3(grid), dim3(NTHR), args, LDS_BYTES, stream);
    if (e != hipSuccess) fprintf(stderr, "cooperative launch failed: %s (grid %d)\n", hipGetErrorString(e), grid);
#endif
}
```

```cpp
#include <hip/hip_runtime.h>
#include <hip/hip_cooperative_groups.h>
#include <cstdio>
#include <cstdint>
namespace cg = cooperative_groups;
#define PROBE_MASK 0
namespace pg8 {
#define PG8_LAS __attribute__((address_space(3)))
typedef unsigned short bf16_t;
typedef short bf16x8 __attribute__((ext_vector_type(8)));
typedef float f32x4 __attribute__((ext_vector_type(4)));
typedef unsigned u32x4 __attribute__((ext_vector_type(4)));
constexpr int BM = 256, BK = 64, HALF = 128, HTB = HALF * BK * 2  , STAGE_BYTES = 8 * HTB, NXCD = 8, WGM = 8;

__host__ __device__ __forceinline__ int lds_byte(int r, int c) { const int st = (r >> 4) * 2 + (c >> 5), rr = r & 15, cc = c & 31, ob = rr * 64 + cc * 2; return st * 1024 + (ob ^ (((ob >> 9) & 1) << 5)); }
__host__ __device__ __forceinline__ void stage_rc(int b, int& R, int& C) { const int st = b / 1024, sb = b % 1024, swz = sb ^ (((sb >> 9) & 1) << 5); R = (st >> 1) * 16 + swz / 64; C = (st & 1) * 32 + (swz % 64) / 2; }
__host__ __device__ __forceinline__ int perm32(int rho) { const int n = rho >> 4, i = rho & 15; return 8 * (i >> 2) + 4 * n + (i & 3); }

struct Unit { int pm, pn; };
struct Gemm { const bf16_t* A; const bf16_t* Bt; int M, N, K; };

struct StaticOrder {
    int nM, nN, nwg, G, c;
    __host__ __device__ void init(int M, int N, int G_, int c_) { nM = M / BM; nN = N / BM; nwg = nM * nN; G = G_; c = c_; }
    __host__ __device__ bool next(int i, Unit& u) const {
        const long L = (long)i * G + c; if (L >= nwg) return false;
        int wgid = (int)L; { const int q = nwg / NXCD, r = nwg % NXCD, xcd = wgid % NXCD, off = wgid / NXCD; wgid = (xcd < r ? xcd * (q + 1) : r * (q + 1) + (xcd - r) * q) + off; }
        const int nig = WGM * nN, gid = wgid / nig, fm = gid * WGM, gsz = (nM - fm) < WGM ? (nM - fm) : WGM;
        u.pm = fm + ((wgid % nig) % gsz); u.pn = (wgid % nig) / gsz; return true;
    }
    __device__ __forceinline__ void a_ready(const Unit&) const {}
    __device__ __forceinline__ void done(const Unit&) const {}
};
__device__ __forceinline__ unsigned cvt_pk_bf16(float lo, float hi) { unsigned r; asm volatile("v_cvt_pk_bf16_f32 %0, %1, %2" : "=v"(r) : "v"(lo), "v"(hi)); return r; }
typedef float f32x2 __attribute__((ext_vector_type(2)));
template <class Epi, class Sched, bool ALIGN_EPI = false, bool SP2 = false>
__device__ __forceinline__ void gemm_phase(PG8_LAS unsigned char* lds, const Gemm g, const Sched& S, const Epi& E, const int tid_in) {
    const int tid = tid_in, wid = __builtin_amdgcn_readfirstlane(tid >> 6), lane = tid & 63, wr = wid >> 2, wc = wid & 3, fr = lane & 15, fq = lane >> 4;
    const int K = g.K, nt = K / BK;
    unsigned voffA[2], voffB[2];
#pragma unroll
    for (int i = 0; i < 2; ++i) { int R, C; stage_rc(tid * 16 + i * 8192, R, C); const int Rb = Epi::PERM ? ((R & ~31) + perm32(R & 31)) : R;
        voffA[i] = (unsigned)(R * K + C) * 2u; voffB[i] = (unsigned)(Rb * K + C) * 2u; }
    const size_t kstep = (size_t)(BK * 2);
    const size_t hstep = (size_t)HALF * K * 2;
    const size_t tstep = 2 * hstep;
    const unsigned ldsw = (unsigned)wid * 1024u;
    const int aoff = lds_byte(wr * 64 + fr, fq * 8), boff = lds_byte(wc * 32 + fr, fq * 8);
#define PG8_SA(b, h) (((b) * 2 + (h)) * HTB)
#define PG8_SB(b, h) ((4 + (b) * 2 + (h)) * HTB)
#define PG8_STAGE(bufoff, gbase, voff) do { _Pragma("unroll") for (int _i = 0; _i < 2; ++_i) \
        __builtin_amdgcn_global_load_lds((const unsigned*)((const char*)(gbase) + (voff)[_i]), (PG8_LAS unsigned*)(lds + (bufoff) + ldsw + _i * 8192), 16, 0, 0); } while (0)
#define PG8_LDA(dst, b, h) do { _Pragma("unroll") for (int m = 0; m < 4; ++m) _Pragma("unroll") for (int k = 0; k < 2; ++k) dst[m][k] = *(const PG8_LAS bf16x8*)(lds + PG8_SA(b, h) + aoff + m * 2048 + k * 1024); } while (0)
#define PG8_LDB(dst, b, h) do { _Pragma("unroll") for (int n = 0; n < 2; ++n) _Pragma("unroll") for (int k = 0; k < 2; ++k) dst[n][k] = *(const PG8_LAS bf16x8*)(lds + PG8_SB(b, h) + boff + n * 2048 + k * 1024); } while (0)
#define PG8_MMA(ai, bj, At, Bt) do { __builtin_amdgcn_s_setprio(1); _Pragma("unroll") for (int m = 0; m < 4; ++m) _Pragma("unroll") for (int n = 0; n < 2; ++n) _Pragma("unroll") for (int k = 0; k < 2; ++k) \
        acc[ai][bj][m][n] = __builtin_amdgcn_mfma_f32_16x16x32_bf16(Bt[n][k], At[m][k], acc[ai][bj][m][n], 0, 0, 0); __builtin_amdgcn_s_setprio(0); } while (0)
#define PG8_WAIT_V(n) asm volatile("s_waitcnt vmcnt(" #n ")" ::: "memory")
#define PG8_WAIT_L(n) asm volatile("s_waitcnt lgkmcnt(" #n ")" ::: "memory")
#define PG8_BAR __builtin_amdgcn_s_barrier()
#define PG8_SCHED __builtin_amdgcn_sched_barrier(0)
    Unit cur, nxt; int ui = 0;
    if (!S.next(0, cur)) return;
    f32x4 acc[2][2][4][2];
#pragma unroll
    for (int a = 0; a < 2; ++a)
#pragma unroll
        for (int b = 0; b < 2; ++b)
#pragma unroll
            for (int m = 0; m < 4; ++m)
#pragma unroll
                for (int n = 0; n < 2; ++n) acc[a][b][m][n] = (f32x4){0.f, 0.f, 0.f, 0.f};
    bf16x8 At[4][2], B0[2][2], B1[2][2];
    const char* cA = (const char*)g.A + (size_t)cur.pm * tstep; const char* cB = (const char*)g.Bt + (size_t)cur.pn * tstep;
    S.a_ready(cur);
    if constexpr (SP2) {
        PG8_STAGE(PG8_SB(0, 0), cB, voffB); PG8_STAGE(PG8_SB(0, 1), cB + hstep, voffB); PG8_STAGE(PG8_SA(0, 0), cA, voffA); PG8_STAGE(PG8_SA(0, 1), cA + hstep, voffA);
        if (wr == 1) PG8_BAR;
        PG8_WAIT_V(2); PG8_BAR;
        PG8_STAGE(PG8_SB(1, 0), cB + kstep, voffB); PG8_STAGE(PG8_SA(1, 0), cA + kstep, voffA); PG8_STAGE(PG8_SB(1, 1), cB + hstep + kstep, voffB);
        PG8_WAIT_V(6); PG8_BAR;
    } else {
        PG8_STAGE(PG8_SB(0, 0), cB, voffB); PG8_STAGE(PG8_SA(0, 0), cA, voffA); PG8_STAGE(PG8_SB(0, 1), cB + hstep, voffB); PG8_STAGE(PG8_SA(0, 1), cA + hstep, voffA);
        if (wr == 1) PG8_BAR;
        PG8_WAIT_V(4); PG8_BAR;
        PG8_STAGE(PG8_SB(1, 0), cB + kstep, voffB); PG8_STAGE(PG8_SA(1, 0), cA + kstep, voffA); PG8_STAGE(PG8_SB(1, 1), cB + hstep + kstep, voffB);
        PG8_WAIT_V(6); PG8_BAR;
    }
    for (;;) {
        const bool has_next = S.next(ui + 1, nxt);
        const char* nA = has_next ? (const char*)g.A + (size_t)nxt.pm * tstep : cA; const char* nB = has_next ? (const char*)g.Bt + (size_t)nxt.pn * tstep : cB;
        for (int t = 0; t < nt; t += 2) {
            const bool last = (t == nt - 2);
            const char* a1 = cA + (size_t)(t + 1) * kstep;
            const char* a2 = last ? nA : cA + (size_t)(t + 2) * kstep; const char* b2 = last ? nB : cB + (size_t)(t + 2) * kstep;
            const char* a3 = a2 + kstep; const char* b3 = b2 + kstep;
            if (last && has_next) S.a_ready(nxt);
            if constexpr (SP2) {
            PG8_LDB(B0, 0, 0); PG8_LDB(B1, 0, 1); PG8_SCHED; PG8_LDA(At, 0, 0); PG8_STAGE(PG8_SA(1, 1), a1 + hstep, voffA);
            PG8_WAIT_V(8); PG8_WAIT_L(0); PG8_BAR; PG8_MMA(0, 0, At, B0); PG8_MMA(0, 1, At, B1); PG8_BAR; PG8_SCHED;
            PG8_LDA(At, 0, 1); PG8_STAGE(PG8_SB(0, 0), b2, voffB); PG8_STAGE(PG8_SB(0, 1), b2 + hstep, voffB); PG8_STAGE(PG8_SA(0, 0), a2, voffA);
            PG8_WAIT_V(8); PG8_WAIT_L(0); PG8_BAR; PG8_MMA(1, 0, At, B0); PG8_MMA(1, 1, At, B1); PG8_BAR; PG8_SCHED;
            PG8_LDB(B0, 1, 0); PG8_LDB(B1, 1, 1); PG8_SCHED; PG8_LDA(At, 1, 0); PG8_STAGE(PG8_SA(0, 1), a2 + hstep, voffA);
            PG8_WAIT_V(8); PG8_WAIT_L(0); PG8_BAR; PG8_MMA(0, 0, At, B0); PG8_MMA(0, 1, At, B1); PG8_BAR; PG8_SCHED;
            PG8_LDA(At, 1, 1); PG8_STAGE(PG8_SB(1, 0), b3, voffB); PG8_STAGE(PG8_SB(1, 1), b3 + hstep, voffB); PG8_STAGE(PG8_SA(1, 0), a3, voffA);
            PG8_WAIT_V(8); PG8_WAIT_L(0); PG8_BAR; PG8_MMA(1, 0, At, B0); PG8_MMA(1, 1, At, B1); PG8_BAR; PG8_SCHED;
            } else {
            PG8_LDB(B0, 0, 0); PG8_SCHED; PG8_LDA(At, 0, 0); PG8_STAGE(PG8_SA(1, 1), a1 + hstep, voffA);
            PG8_WAIT_L(8); PG8_BAR; PG8_WAIT_L(0); PG8_MMA(0, 0, At, B0); PG8_BAR; PG8_SCHED;
            PG8_LDB(B1, 0, 1); PG8_STAGE(PG8_SB(0, 0), b2, voffB);
            PG8_BAR; PG8_WAIT_L(0); PG8_MMA(0, 1, At, B1); PG8_BAR;
            PG8_LDA(At, 0, 1); PG8_STAGE(PG8_SA(0, 0), a2, voffA);
            PG8_BAR; PG8_WAIT_L(0); PG8_MMA(1, 0, At, B0); PG8_BAR; PG8_SCHED;
            PG8_STAGE(PG8_SB(0, 1), b2 + hstep, voffB);
            PG8_WAIT_V(6); PG8_BAR; PG8_MMA(1, 1, At, B1); PG8_BAR;
            PG8_LDB(B0, 1, 0); PG8_SCHED; PG8_LDA(At, 1, 0); PG8_STAGE(PG8_SA(0, 1), a2 + hstep, voffA);
            PG8_WAIT_L(8); PG8_BAR; PG8_WAIT_L(0); PG8_MMA(0, 0, At, B0); PG8_BAR; PG8_SCHED;
            PG8_LDB(B1, 1, 1); PG8_STAGE(PG8_SB(1, 0), b3, voffB);
            PG8_BAR; PG8_WAIT_L(0); PG8_MMA(0, 1, At, B1); PG8_BAR;
            PG8_LDA(At, 1, 1); PG8_STAGE(PG8_SA(1, 0), a3, voffA);
            PG8_BAR; PG8_WAIT_L(0); PG8_MMA(1, 0, At, B0); PG8_BAR; PG8_SCHED;
            PG8_STAGE(PG8_SB(1, 1), b3 + hstep, voffB);
            PG8_WAIT_V(6); PG8_BAR; PG8_MMA(1, 1, At, B1); PG8_BAR;
            }
        }
        if constexpr (ALIGN_EPI) { if (wr == 0) PG8_BAR; }
        if constexpr (!Epi::AFTER_DRAIN) { E(acc, cur, wr, wc, fr, fq); S.done(cur); }
        if (!has_next) break;
#pragma unroll
        for (int a = 0; a < 2; ++a)
#pragma unroll
            for (int b = 0; b < 2; ++b)
#pragma unroll
                for (int m = 0; m < 4; ++m)
#pragma unroll
                    for (int n = 0; n < 2; ++n) acc[a][b][m][n] = (f32x4){0.f, 0.f, 0.f, 0.f};
        cur = nxt; cA = nA; cB = nB; ++ui;
        if constexpr (ALIGN_EPI) { if (wr == 1) PG8_BAR; }
    }
    PG8_WAIT_V(0);
    if constexpr (!ALIGN_EPI) { if (wr == 0) PG8_BAR; }
    PG8_BAR;
    if constexpr (Epi::AFTER_DRAIN) { E.fused(acc, cur, wr, wc, fr, fq, lds, wid, lane); S.done(cur); }
#undef PG8_SA
#undef PG8_SB
#undef PG8_STAGE
#undef PG8_LDA
#undef PG8_LDB
#undef PG8_MMA
#undef PG8_WAIT_V
#undef PG8_WAIT_L
#undef PG8_BAR
#undef PG8_SCHED
}
}

#define LAS __attribute__((address_space(3)))
typedef unsigned short bf16_t;
typedef short bf16x8 __attribute__((ext_vector_type(8)));
typedef short s16x4 __attribute__((ext_vector_type(4)));
typedef float f32x2 __attribute__((ext_vector_type(2)));
typedef float f32x4 __attribute__((ext_vector_type(4)));
typedef float f32x16 __attribute__((ext_vector_type(16)));
typedef unsigned u32x2 __attribute__((ext_vector_type(2)));
typedef unsigned u32x4 __attribute__((ext_vector_type(4)));
#define MFMA32(a, b, c) __builtin_amdgcn_mfma_f32_32x32x16_bf16((a), (b), (c), 0, 0, 0)

constexpr int NWAVES = 8, NTHR = 512;
constexpr int BATCH = 4, SEQ = 8192, DM = 1024, MTOK = BATCH * SEQ, INW = 2568, NPROJ = 2560, DFF = 4096, PLED = 256, DEPTH = 2;
constexpr int C_POOL = 0, C_Q = 256, C_K = 512, C_V = 768, C_Z = 1024, C_XBC = 1536;
constexpr int NCHUNK = SEQ / 128;
constexpr float LN_EPS = 1e-5f;
constexpr float ALPHA = 1.41421356237309515f;
constexpr float LOG2E = 1.4426950408889634f;

constexpr size_t MiB = 1u << 20;
constexpr size_t WS_STATS = 0;
constexpr size_t WS_DTRAW = 1 * MiB;
constexpr size_t WS_WDT = 2 * MiB;
constexpr size_t WS_POOLW = 2 * MiB + 256 * 1024;
constexpr size_t WS_CDEC = 2 * MiB + 512 * 1024;
constexpr size_t WS_TS = 3 * MiB;
constexpr size_t WS_W = 4 * MiB, W_STRIDE = 26 * MiB;
constexpr size_t W_IN = 0, W_OUT = 5 * MiB, W_FF1G = 7 * MiB, W_FF2 = 17 * MiB, W_PLE = 25 * MiB;
constexpr size_t WS_HB = 56 * MiB;
constexpr size_t WS_PB = 120 * MiB;
constexpr size_t WS_FFA = 152 * MiB;
constexpr size_t WS_PROJ = 152 * MiB;
constexpr size_t WS_MIXO = 312 * MiB;
constexpr size_t WS_PG = 408 * MiB;
constexpr size_t WS_STATES = 408 * MiB;
constexpr size_t WS_END = 472 * MiB;
constexpr int LDS_MISC = 153600, LDS_BYTES = 153600 + 64;
constexpr size_t WS_BAR = 3 * MiB + 65536, BAR_BYTES = 16384;

__device__ __forceinline__ float bf2f(unsigned short u) { return __uint_as_float(((unsigned)u) << 16); }
__device__ __forceinline__ float bflo(unsigned u) { return __uint_as_float(u << 16); }
__device__ __forceinline__ float bfhi(unsigned u) { return __uint_as_float(u & 0xffff0000u); }
__device__ __forceinline__ unsigned pk2(float lo, float hi) { return pg8::cvt_pk_bf16(lo, hi); }
__device__ __forceinline__ float wave_sum(float v) {
#pragma unroll
    for (int o = 1; o < 64; o <<= 1) v += __shfl_xor(v, o);
    return v;
}
__device__ __forceinline__ float fast_sigmoid(float x) { return __builtin_amdgcn_rcpf(1.0f + __builtin_amdgcn_exp2f(-x * LOG2E)); }
__device__ __forceinline__ int crow(int r, int hi) { return (r & 3) + 8 * (r >> 2) + 4 * hi; }

using pg8::Unit;
struct EpiStoreBf16 {
    static constexpr bool PERM = true, AFTER_DRAIN = false;
    bf16_t* O; int ldc;
    __device__ __forceinline__ void operator()(const f32x4 (&acc)[2][2][4][2], const Unit& u, int wr, int wc, int fr, int fq) const {
        const int row0 = u.pm * 256 + wr * 64 + fr, col0 = u.pn * 256 + wc * 32 + 8 * fq;
#pragma unroll
        for (int ai = 0; ai < 2; ++ai)
#pragma unroll
            for (int m = 0; m < 4; ++m) { bf16_t* rowp = O + (size_t)(row0 + ai * 128 + m * 16) * ldc + col0;
#pragma unroll
                for (int bj = 0; bj < 2; ++bj) { const f32x4 v0 = acc[ai][bj][m][0], v1 = acc[ai][bj][m][1];
                    u32x4 w; w.x = pk2(v0[0], v0[1]); w.y = pk2(v0[2], v0[3]); w.z = pk2(v1[0], v1[1]); w.w = pk2(v1[2], v1[3]);
                    *(u32x4*)(rowp + bj * 128) = w; } }
    }
};
struct EpiFf1Gate {
    static constexpr bool PERM = true, AFTER_DRAIN = false;
    bf16_t* FFA; bf16_t* PG;
    __device__ __forceinline__ void operator()(const f32x4 (&acc)[2][2][4][2], const Unit& u, int wr, int wc, int fr, int fq) const {
        const int row0 = u.pm * 256 + wr * 64 + fr;
        if (u.pn < 16) {
            const int col0 = u.pn * 256 + wc * 32 + 8 * fq;
#pragma unroll
            for (int ai = 0; ai < 2; ++ai)
#pragma unroll
                for (int m = 0; m < 4; ++m) { bf16_t* rowp = FFA + (size_t)(row0 + ai * 128 + m * 16) * DFF + col0;
#pragma unroll
                    for (int bj = 0; bj < 2; ++bj) { f32x4 v0 = acc[ai][bj][m][0], v1 = acc[ai][bj][m][1];
#pragma unroll
                        for (int e = 0; e < 4; ++e) { const float a = fmaxf(v0[e], 0.f), b = fmaxf(v1[e], 0.f); v0[e] = a * a; v1[e] = b * b; }
                        u32x4 w; w.x = pk2(v0[0], v0[1]); w.y = pk2(v0[2], v0[3]); w.z = pk2(v1[0], v1[1]); w.w = pk2(v1[2], v1[3]);
                        *(u32x4*)(rowp + bj * 128) = w; } }
        } else {
            const int col0 = (u.pn - 16) * 256 + wc * 32 + 8 * fq;
#pragma unroll
            for (int ai = 0; ai < 2; ++ai)
#pragma unroll
                for (int m = 0; m < 4; ++m) { bf16_t* rowp = PG + (size_t)(row0 + ai * 128 + m * 16) * DM + col0;
#pragma unroll
                    for (int bj = 0; bj < 2; ++bj) { const f32x4 v0 = acc[ai][bj][m][0], v1 = acc[ai][bj][m][1];
                        const u32x4 t = *(const u32x4*)(rowp + bj * 128);
                        u32x4 w;
                        w.x = pk2(bflo(t.x) * fast_sigmoid(v0[0]), bfhi(t.x) * fast_sigmoid(v0[1]));
                        w.y = pk2(bflo(t.y) * fast_sigmoid(v0[2]), bfhi(t.y) * fast_sigmoid(v0[3]));
                        w.z = pk2(bflo(t.z) * fast_sigmoid(v1[0]), bfhi(t.z) * fast_sigmoid(v1[1]));
                        w.w = pk2(bflo(t.w) * fast_sigmoid(v1[2]), bfhi(t.w) * fast_sigmoid(v1[3]));
                        *(u32x4*)(rowp + bj * 128) = w; } }
        }
    }
};
struct EpiResid {
    static constexpr bool PERM = false, AFTER_DRAIN = false;
    const float* src; float* dst; const float* stats; const float* gam; const float* bet; const bf16_t* PG;
    __device__ __forceinline__ void operator()(const f32x4 (&acc)[2][2][4][2], const Unit& u, int wr, int wc, int fr, int fq) const {
        const int row0 = u.pm * 256 + wr * 64 + fr;
        f32x2 st[2][4];
#pragma unroll
        for (int ai = 0; ai < 2; ++ai)
#pragma unroll
            for (int m = 0; m < 4; ++m) st[ai][m] = *(const f32x2*)(stats + 2 * (size_t)(row0 + ai * 128 + m * 16));
#pragma unroll
        for (int bj = 0; bj < 2; ++bj)
#pragma unroll
            for (int n = 0; n < 2; ++n) {
                const int col = u.pn * 256 + bj * 128 + wc * 32 + n * 16 + 4 * fq;
                const f32x4 g4 = *(const f32x4*)(gam + col), b4 = *(const f32x4*)(bet + col);
#pragma unroll
                for (int ai = 0; ai < 2; ++ai)
#pragma unroll
                    for (int m = 0; m < 4; ++m) {
                        const size_t off = (size_t)(row0 + ai * 128 + m * 16) * DM + col;
                        const f32x4 x4 = *(const f32x4*)(src + off);
                        f32x4 o = ((x4 - st[ai][m].x) * st[ai][m].y * g4 + b4) * ALPHA + acc[ai][bj][m][n];
                        if (PG) { const u32x2 t = *(const u32x2*)(PG + off); o[0] += bflo(t.x); o[1] += bfhi(t.x); o[2] += bflo(t.y); o[3] += bfhi(t.y); }
                        *(f32x4*)(dst + off) = o;
                    }
            }
    }
};

struct Args { const float* in[27]; float* out; unsigned char* ws; int ph_lo, ph_hi; };
struct Frame {
    LAS unsigned char* lds; unsigned char* ldsg;
    int tid, lane, wave, G, gw, NGW, bid; unsigned probeN;
    unsigned char* ws;
};

__device__ __forceinline__ void transpose_item(const float* W, int ldw, int K, int nblk, bf16_t* WT, int row_off, LAS float* scr, int item, int lane) {
    const int kb = item / nblk, nb = item % nblk, k0 = 64 * kb, n0 = 32 * nb;
#pragma unroll 8
    for (int i = 0; i < 32; ++i) { const int kk = 2 * i + (lane >> 5); scr[kk * 33 + (lane & 31)] = W[(size_t)(k0 + kk) * ldw + n0 + (lane & 31)]; }
    asm volatile("s_waitcnt lgkmcnt(0)" ::: "memory");
    const int c = lane & 7;
#pragma unroll
    for (int j = 0; j < 4; ++j) { const int n = (lane >> 3) + 8 * j; const LAS float* s = scr + (8 * c) * 33 + n;
        u32x4 o; o.x = pk2(s[0 * 33], s[1 * 33]); o.y = pk2(s[2 * 33], s[3 * 33]); o.z = pk2(s[4 * 33], s[5 * 33]); o.w = pk2(s[6 * 33], s[7 * 33]);
        *(u32x4*)(WT + (size_t)(row_off + n0 + n) * K + k0 + 8 * c) = o; }
    asm volatile("s_waitcnt lgkmcnt(0)" ::: "memory");
}
typedef __bf16 bf16x2_t __attribute__((ext_vector_type(2)));
__device__ __forceinline__ float dot2bf(unsigned a, unsigned b, float c) { return __builtin_amdgcn_fdot2_f32_bf16(__builtin_bit_cast(bf16x2_t, a), __builtin_bit_cast(bf16x2_t, b), c, false); }
__device__ __forceinline__ float reduce8(const float (&d)[8], int lane) {
    float a[4];
    { const bool up = (lane & 32) != 0;
#pragma unroll
      for (int i = 0; i < 4; ++i) { const float keep = up ? d[4 + i] : d[i], send = up ? d[i] : d[4 + i]; a[i] = keep + __shfl_xor(send, 32); } }
    float b[2];
    { const bool up = (lane & 16) != 0;
#pragma unroll
      for (int i = 0; i < 2; ++i) { const float keep = up ? a[2 + i] : a[i], send = up ? a[i] : a[2 + i]; b[i] = keep + __shfl_xor(send, 16); } }
    float c;
    { const bool up = (lane & 8) != 0; const float keep = up ? b[1] : b[0], send = up ? b[0] : b[1]; c = keep + __shfl_xor(send, 8); }
    c += __shfl_xor(c, 4); c += __shfl_xor(c, 2); c += __shfl_xor(c, 1);
    return c;
}
template <bool FINAL, bool DT>
__device__ __forceinline__ void ln_rows(const Frame& F, const float* src, const float* gam, const float* bet, bf16_t* hb, float* stats, const unsigned* wdtp, float* dtraw, float* fout) {
    f32x4 g[4], b[4];
#pragma unroll
    for (int j = 0; j < 4; ++j) { g[j] = *(const f32x4*)(gam + 4 * F.lane + 256 * j); b[j] = *(const f32x4*)(bet + 4 * F.lane + 256 * j); }
    u32x2 wd[8][4];
    if (DT) {
#pragma unroll
        for (int h = 0; h < 8; ++h)
#pragma unroll
            for (int j = 0; j < 4; ++j) wd[h][j] = *(const u32x2*)(wdtp + h * 512 + 128 * j + 2 * F.lane);
    }
    const int lane = F.lane, NGW = F.NGW; const unsigned probeN = F.probeN;
    auto ldrow = [&](f32x4 (&v)[4], int row) __attribute__((always_inline)) {
        if (row < MTOK) { const float* xr = src + (size_t)row * DM + 4 * lane;
#pragma unroll
            for (int j = 0; j < 4; ++j) v[j] = *(const f32x4*)(xr + 256 * j); } };
    auto proc = [&](f32x4 (&v)[4], int row) __attribute__((always_inline)) {
        if (row >= MTOK) return;
        float s = 0.f;
#pragma unroll
        for (int j = 0; j < 4; ++j) s += (v[j][0] + v[j][1]) + (v[j][2] + v[j][3]);
        const float mean = wave_sum(s) * (1.f / DM); float s2 = 0.f;
#pragma unroll
        for (int j = 0; j < 4; ++j) { v[j] = v[j] - mean; s2 += (v[j][0] * v[j][0] + v[j][1] * v[j][1]) + (v[j][2] * v[j][2] + v[j][3] * v[j][3]); }
        const float rstd = 1.0f / sqrtf(wave_sum(s2) * (1.f / DM) + LN_EPS);
#pragma unroll
        for (int j = 0; j < 4; ++j) v[j] = v[j] * rstd * g[j] + b[j];
        if (FINAL) {
#if PROBE_MASK
#pragma unroll
            for (int j = 0; j < 4; ++j)
#pragma unroll
                for (int e = 0; e < 4; ++e) if ((unsigned)(row * DM + 4 * lane + 256 * j + e) < probeN) v[j][e] += 0.125f;
#endif
#pragma unroll
            for (int j = 0; j < 4; ++j) *(f32x4*)(fout + (size_t)row * DM + 4 * lane + 256 * j) = v[j];
        } else {
            if (lane == 0) *(f32x2*)(stats + 2 * (size_t)row) = (f32x2){mean, rstd};
            u32x2 w[4];
#pragma unroll
            for (int j = 0; j < 4; ++j) { w[j].x = pk2(v[j][0], v[j][1]); w[j].y = pk2(v[j][2], v[j][3]); *(u32x2*)(hb + (size_t)row * DM + 4 * lane + 256 * j) = w[j]; }
            if (DT) {
                float d[8];
#pragma unroll
                for (int h = 0; h < 8; ++h) { float acc = 0.f;
#pragma unroll
                    for (int j = 0; j < 4; ++j) { acc = dot2bf(w[j].x, wd[h][j].x, acc); acc = dot2bf(w[j].y, wd[h][j].y, acc); }
                    d[h] = acc; }
                const float tot = reduce8(d, lane);
                if ((lane & 7) == 0) dtraw[(size_t)row * 8 + (lane >> 3)] = tot;
            }
        }
    };
    f32x4 v0[4], v1[4], v2[4], v3[4];
    int row = F.gw;
    ldrow(v0, row); ldrow(v1, row + NGW); ldrow(v2, row + 2 * NGW); ldrow(v3, row + 3 * NGW);
    for (; row < MTOK; row += 4 * NGW) {
        proc(v0, row);           ldrow(v0, row + 4 * NGW);
        proc(v1, row + NGW);     ldrow(v1, row + 5 * NGW);
        proc(v2, row + 2 * NGW); ldrow(v2, row + 6 * NGW);
        proc(v3, row + 3 * NGW); ldrow(v3, row + 7 * NGW);
    }
}
__device__ __forceinline__ void p0_prologue(const Frame& F, const Args& a) {
    LAS float* scr = (LAS float*)(F.lds + F.wave * 8704);
    unsigned char* ws = F.ws;
    constexpr int I_IN = 16 * 80, I_OUT = 16 * 32, I_FF1 = 16 * 128, I_G = 16 * 32, I_FF2 = 64 * 32, I_PLE = 4 * 32, I_L = I_IN + I_OUT + I_FF1 + I_G + I_FF2 + I_PLE;
    for (int it = F.gw; it < DEPTH * I_L; it += F.NGW) {
        const int l = it / I_L; int r = it % I_L;
        unsigned char* wb = ws + WS_W + (size_t)l * W_STRIDE;
        if (r < I_IN) { transpose_item(a.in[4] + (size_t)l * DM * INW, INW, DM, 80, (bf16_t*)(wb + W_IN), 0, scr, r, F.lane); continue; } r -= I_IN;
        if (r < I_OUT) { transpose_item(a.in[18] + (size_t)l * DM * DM, DM, DM, 32, (bf16_t*)(wb + W_OUT), 0, scr, r, F.lane); continue; } r -= I_OUT;
        if (r < I_FF1) { transpose_item(a.in[21] + (size_t)l * DM * DFF, DFF, DM, 128, (bf16_t*)(wb + W_FF1G), 0, scr, r, F.lane); continue; } r -= I_FF1;
        if (r < I_G) { transpose_item(a.in[24] + (size_t)l * DM * DM, DM, DM, 32, (bf16_t*)(wb + W_FF1G), DFF, scr, r, F.lane); continue; } r -= I_G;
        if (r < I_FF2) { transpose_item(a.in[22] + (size_t)l * DFF * DM, DM, DFF, 32, (bf16_t*)(wb + W_FF2), 0, scr, r, F.lane); continue; } r -= I_FF2;
        transpose_item(a.in[23] + (size_t)l * PLED * DM, DM, PLED, 32, (bf16_t*)(wb + W_PLE), 0, scr, r, F.lane);
    }
    const int gt = F.bid * NTHR + F.tid, NT = F.G * NTHR;
    {
        const float* p = a.in[1]; bf16_t* pb = (bf16_t*)(ws + WS_PB);
        for (size_t i = gt; i < (size_t)DEPTH * MTOK * PLED / 8; i += NT) { const f32x4 x0 = *(const f32x4*)(p + 8 * i), x1 = *(const f32x4*)(p + 8 * i + 4);
            u32x4 w; w.x = pk2(x0[0], x0[1]); w.y = pk2(x0[2], x0[3]); w.z = pk2(x1[0], x1[1]); w.w = pk2(x1[2], x1[3]); *(u32x4*)(pb + 8 * i) = w; }
    }
    {
        unsigned* wdt = (unsigned*)(ws + WS_WDT); bf16_t* pw = (bf16_t*)(ws + WS_POOLW);
        for (int i = gt; i < DEPTH * 8 * 512; i += NT) { const int l = i >> 12, j = (i >> 9) & 7, k = 2 * (i & 511); wdt[i] = pk2(a.in[4][((size_t)l * DM + k) * INW + NPROJ + j], a.in[4][((size_t)l * DM + k + 1) * INW + NPROJ + j]); }
        for (int i = gt; i < DEPTH * 4 * 64 * 64; i += NT) { const int lg = i >> 12, d = (i >> 6) & 63, c = i & 63; pw[i] = (bf16_t)(pk2(a.in[5][(size_t)lg * 4096 + c * 64 + d], 0.f) & 0xffffu); }
    }
    ln_rows<false, false>(F, a.in[0], a.in[2], a.in[3], (bf16_t*)(ws + WS_HB), (float*)(ws + WS_STATS), nullptr, nullptr, nullptr);
}
__device__ __forceinline__ void dtraw_from_hb(const Frame& F, const bf16_t* hb, const unsigned* wdtp, float* dtraw) {
    u32x2 wd[8][4];
#pragma unroll
    for (int h = 0; h < 8; ++h)
#pragma unroll
        for (int j = 0; j < 4; ++j) wd[h][j] = *(const u32x2*)(wdtp + h * 512 + 128 * j + 2 * F.lane);
    for (int row0 = F.gw; row0 < MTOK; row0 += 4 * F.NGW) {
        u32x2 w[4][4];
#pragma unroll
        for (int r = 0; r < 4; ++r) { const int row = row0 + r * F.NGW; if (row < MTOK) {
#pragma unroll
            for (int j = 0; j < 4; ++j) w[r][j] = *(const u32x2*)(hb + (size_t)row * DM + 4 * F.lane + 256 * j); } }
#pragma unroll
        for (int r = 0; r < 4; ++r) { const int row = row0 + r * F.NGW; if (row < MTOK) {
            float d[8];
#pragma unroll
            for (int h = 0; h < 8; ++h) { float acc = 0.f;
#pragma unroll
                for (int j = 0; j < 4; ++j) { acc = dot2bf(w[r][j].x, wd[h][j].x, acc); acc = dot2bf(w[r][j].y, wd[h][j].y, acc); }
                d[h] = acc; }
            const float tot = reduce8(d, F.lane);
            if ((F.lane & 7) == 0) dtraw[(size_t)row * 8 + (F.lane >> 3)] = tot; } }
    }
}

constexpr int L_TAB_DT = 143360, L_TAB_ACS = 147456, L_TAB_PART = 151552;
constexpr int CPITCH = 136;
__device__ __forceinline__ void ssd_tables(const Frame& F, const float* dtraw, const float* dt_bias, const float* a_log, int row0) {
    LAS float* dtv = (LAS float*)(F.lds + L_TAB_DT); LAS float* acs = (LAS float*)(F.lds + L_TAB_ACS);
    const int hd = F.wave, l0 = 2 * F.lane;
    const float bias = dt_bias[hd], A = -expf(a_log[hd]);
    const float x0 = dtraw[(size_t)(row0 + l0) * 8 + hd] + bias, x1 = dtraw[(size_t)(row0 + l0 + 1) * 8 + hd] + bias;
    const float d0 = fmaxf(x0, 0.f) + log1pf(expf(-fabsf(x0))), d1 = fmaxf(x1, 0.f) + log1pf(expf(-fabsf(x1)));
    const float a0 = d0 * A, a1 = d1 * A;
    float s = a0 + a1;
#pragma unroll
    for (int o = 1; o < 64; o <<= 1) { const float t = __shfl_up(s, o); if (F.lane >= o) s += t; }
    dtv[l0 * 8 + hd] = d0; dtv[(l0 + 1) * 8 + hd] = d1; acs[l0 * 8 + hd] = s - a1; acs[(l0 + 1) * 8 + hd] = s;
}
__device__ __forceinline__ void conv8(const bf16_t* proj, const float* cw, const float* cb, size_t rowbase, int t0, int cch, float (&o0)[8], float (&o1)[8]) {
    float xl[11], xh[11];
#pragma unroll
    for (int i = 0; i < 11; ++i) { const int t = t0 - 3 + i; unsigned v = 0u; if (t >= 0) v = *(const unsigned*)(proj + (rowbase + t) * NPROJ + C_XBC + cch); xl[i] = bflo(v); xh[i] = bfhi(v); }
    float w0[4], w1[4];
#pragma unroll
    for (int k = 0; k < 4; ++k) { const f32x2 w = *(const f32x2*)(cw + k * 1024 + cch); w0[k] = w.x; w1[k] = w.y; }
    const f32x2 bb = *(const f32x2*)(cb + cch);
#pragma unroll
    for (int j = 0; j < 8; ++j) {
        float y0 = bb.x, y1 = bb.y;
#pragma unroll
        for (int k = 0; k < 4; ++k) { y0 += w0[k] * xl[j + k]; y1 += w1[k] * xh[j + k]; }
        o0[j] = y0 * fast_sigmoid(y0); o1[j] = y1 * fast_sigmoid(y1);
    }
}

__device__ __forceinline__ void pool_c1_unit(const Frame& F, const Args& a, int layer, int unit) {
    const int b = unit / NCHUNK, c = unit % NCHUNK; const size_t rowbase = (size_t)b * SEQ; const int tc0 = c * 128;
    const bf16_t* proj = (const bf16_t*)(F.ws + WS_PROJ); bf16_t* mixo = (bf16_t*)(F.ws + WS_MIXO);
    const int tid = F.tid, lane = F.lane, wid = F.wave, r32 = lane & 31, hi = lane >> 5;
    {
        constexpr int PP = 264;
        LAS bf16_t* Pl = (LAS bf16_t*)F.lds;
        const int cp = tid & 127, sg = tid >> 7, gi = cp >> 5, w = 2 << gi;
        const bf16_t* up = proj + rowbase * NPROJ + C_POOL + 2 * cp;
        const int t0 = tc0 + sg * 32;
        float s0 = 0.f, s1 = 0.f;
        for (int i = 1; i < w; ++i) { const int t = t0 - i; if (t >= 0) { const unsigned v = *(const unsigned*)(up + (size_t)t * NPROJ); s0 += bflo(v); s1 += bfhi(v); } }
        for (int j = 0; j < 32; ++j) {
            const int t = t0 + j; const unsigned v = *(const unsigned*)(up + (size_t)t * NPROJ); const float u0 = bflo(v), u1 = bfhi(v);
            s0 += u0; s1 += u1;
            const float inv = 1.0f / (float)min(t + 1, w);
            *(LAS unsigned*)(Pl + (sg * 32 + j) * PP + 2 * cp) = pk2(s0 * inv - u0, s1 * inv - u1);
            const int tl = t - w + 1; if (tl >= 0) { const unsigned q = *(const unsigned*)(up + (size_t)tl * NPROJ); s0 -= bflo(q); s1 -= bfhi(q); }
        }
        __syncthreads();
        const int gw4 = wid >> 1, dt = wid & 1;
        const bf16_t* pw = (const bf16_t*)(F.ws + WS_POOLW) + ((size_t)(layer * 4 + gw4) * 64 + dt * 32 + r32) * 64;
        bf16x8 bfr[4];
#pragma unroll
        for (int ks = 0; ks < 4; ++ks) bfr[ks] = *(const bf16x8*)(pw + ks * 16 + hi * 8);
        const float sc = a.in[6][layer * 256 + gw4 * 64 + dt * 32 + r32];
#pragma unroll
        for (int tt = 0; tt < 4; ++tt) {
            f32x16 acc = {};
#pragma unroll
            for (int ks = 0; ks < 4; ++ks) { const bf16x8 af = *(const LAS bf16x8*)(Pl + (tt * 32 + r32) * PP + gw4 * 64 + ks * 16 + hi * 8); acc = MFMA32(af, bfr[ks], acc); }
            bf16_t* op = mixo + (rowbase + tc0 + tt * 32) * DM + C_POOL + gw4 * 64 + dt * 32 + r32;
#pragma unroll
            for (int j = 0; j < 16; ++j) op[(size_t)crow(j, hi) * DM] = (bf16_t)(pk2(acc[j] * sc, 0.f) & 0xffffu);
        }
        __syncthreads();
    }
    const float* dtraw = (const float*)(F.ws + WS_DTRAW);
    ssd_tables(F, dtraw, a.in[14] + layer * 8, a.in[15] + layer * 8, (int)rowbase + tc0);
    __syncthreads();
    LAS float* dtv = (LAS float*)(F.lds + L_TAB_DT); LAS float* acs = (LAS float*)(F.lds + L_TAB_ACS);
    const float* cw = a.in[12] + (size_t)layer * 4 * 1024; const float* cb = a.in[13] + (size_t)layer * 1024;
    LAS bf16_t* XS = (LAS bf16_t*)F.lds;
    LAS bf16_t* BT = (LAS bf16_t*)(F.lds + 256 * CPITCH * 2);
    float* states = (float*)(F.ws + WS_STATES);
    if (tid < 8) ((float*)(F.ws + WS_CDEC))[(size_t)unit * 8 + tid] = expf(acs[127 * 8 + tid]);
    for (int g = 0; g < 2; ++g) {
        for (int it = tid; it < 192 * 16; it += NTHR) {
            const int cpi = it % 192, oct = it / 192;
            const bool isx = cpi < 128;
            const int chl = isx ? 2 * cpi : 2 * (cpi - 128);
            const int cch = isx ? g * 256 + chl : 512 + g * 128 + chl;
            float o0[8], o1[8];
            conv8(proj, cw, cb, rowbase, tc0 + oct * 8, cch, o0, o1);
            if (isx) { const int hd = g * 4 + (chl >> 6); const float al = acs[127 * 8 + hd];
#pragma unroll
                for (int j = 0; j < 8; ++j) { const int l = oct * 8 + j; const float sc = dtv[l * 8 + hd] * __builtin_amdgcn_exp2f((al - acs[l * 8 + hd]) * LOG2E); o0[j] *= sc; o1[j] *= sc; } }
            LAS bf16_t* dst = (isx ? XS : BT) + chl * CPITCH + oct * 8;
            u32x4 w0, w1;
            w0.x = pk2(o0[0], o0[1]); w0.y = pk2(o0[2], o0[3]); w0.z = pk2(o0[4], o0[5]); w0.w = pk2(o0[6], o0[7]);
            w1.x = pk2(o1[0], o1[1]); w1.y = pk2(o1[2], o1[3]); w1.z = pk2(o1[4], o1[5]); w1.w = pk2(o1[6], o1[7]);
            *(LAS u32x4*)dst = w0; *(LAS u32x4*)(dst + CPITCH) = w1;
        }
        __syncthreads();
        {
            const int r = wid >> 1, pt = wid & 1;
            f32x16 acc[4] = {};
#pragma unroll
            for (int ks = 0; ks < 8; ++ks) {
                const bf16x8 af = *(const LAS bf16x8*)(XS + (r * 64 + pt * 32 + r32) * CPITCH + ks * 16 + hi * 8);
#pragma unroll
                for (int nt = 0; nt < 4; ++nt) { const bf16x8 bf = *(const LAS bf16x8*)(BT + (nt * 32 + r32) * CPITCH + ks * 16 + hi * 8); acc[nt] = MFMA32(af, bf, acc[nt]); }
            }
            float* sp = states + ((size_t)unit * 8 + g * 4 + r) * 8192;
#pragma unroll
            for (int nt = 0; nt < 4; ++nt)
#pragma unroll
                for (int j = 0; j < 16; ++j) sp[(pt * 32 + crow(j, hi)) * 128 + nt * 32 + r32] = acc[nt][j];
        }
        __syncthreads();
    }
}

__device__ __forceinline__ void scan_phase(const Frame& F) {
    float* states = (float*)(F.ws + WS_STATES); const float* cdec = (const float*)(F.ws + WS_CDEC);
    const int gt = F.bid * NTHR + F.tid, NT = F.G * NTHR;
    for (int idx = gt; idx < BATCH * 8 * 8192; idx += NT) {
        const int b = idx >> 16, hd = (idx >> 13) & 7, e = idx & 8191;
        float h = 0.f;
        for (int c0 = 0; c0 < NCHUNK; c0 += 8) {
            float st[8], dc[8];
#pragma unroll
            for (int i = 0; i < 8; ++i) { const size_t ch = (size_t)(b * NCHUNK + c0 + i) * 8 + hd; st[i] = states[ch * 8192 + e]; dc[i] = cdec[ch]; }
#pragma unroll
            for (int i = 0; i < 8; ++i) { const size_t ch = (size_t)(b * NCHUNK + c0 + i) * 8 + hd; states[ch * 8192 + e] = h; h = h * dc[i] + st[i]; }
        }
    }
}

__device__ __forceinline__ void c3_unit(const Frame& F, const Args& a, int layer, int unit) {
    const int b = unit / NCHUNK, c = unit % NCHUNK; const size_t rowbase = (size_t)b * SEQ; const int tc0 = c * 128;
    const bf16_t* proj = (const bf16_t*)(F.ws + WS_PROJ); bf16_t* mixo = (bf16_t*)(F.ws + WS_MIXO);
    const int tid = F.tid, lane = F.lane, wid = F.wave, r32 = lane & 31, hi = lane >> 5;
    const float* dtraw = (const float*)(F.ws + WS_DTRAW);
    __syncthreads();
    ssd_tables(F, dtraw, a.in[14] + layer * 8, a.in[15] + layer * 8, (int)rowbase + tc0);
    LAS float* dtv = (LAS float*)(F.lds + L_TAB_DT); LAS float* acs = (LAS float*)(F.lds + L_TAB_ACS); LAS float* part = (LAS float*)(F.lds + L_TAB_PART);
    const float* cw = a.in[12] + (size_t)layer * 4 * 1024; const float* cb = a.in[13] + (size_t)layer * 1024;
    LAS bf16_t* XS = (LAS bf16_t*)F.lds;
    LAS bf16_t* BM = (LAS bf16_t*)(F.lds + 256 * CPITCH * 2);
    LAS bf16_t* CM = (LAS bf16_t*)(F.lds + 384 * CPITCH * 2);
    const float* states = (const float*)(F.ws + WS_STATES);
    const int lt = wid & 3, hp = wid >> 2, l = lt * 32 + r32;
    for (int g = 0; g < 2; ++g) {
        for (int it = tid; it < 256 * 16; it += NTHR) {
            const int cpi = it & 255, oct = it >> 8;
            const int sec = cpi < 128 ? 0 : (cpi < 192 ? 1 : 2);
            const int chl = sec == 0 ? 2 * cpi : (sec == 1 ? 2 * (cpi - 128) : 2 * (cpi - 192));
            const int cch = sec == 0 ? g * 256 + chl : (sec == 1 ? 512 + g * 128 + chl : 768 + g * 128 + chl);
            float o0[8], o1[8];
            conv8(proj, cw, cb, rowbase, tc0 + oct * 8, cch, o0, o1);
            if (sec == 0) {
                LAS bf16_t* dst = XS + chl * CPITCH + oct * 8; u32x4 w0, w1;
                w0.x = pk2(o0[0], o0[1]); w0.y = pk2(o0[2], o0[3]); w0.z = pk2(o0[4], o0[5]); w0.w = pk2(o0[6], o0[7]);
                w1.x = pk2(o1[0], o1[1]); w1.y = pk2(o1[2], o1[3]); w1.z = pk2(o1[4], o1[5]); w1.w = pk2(o1[6], o1[7]);
                *(LAS u32x4*)dst = w0; *(LAS u32x4*)(dst + CPITCH) = w1;
            } else {
                LAS bf16_t* dst = (sec == 1 ? BM : CM) + (oct * 8) * CPITCH + chl;
#pragma unroll
                for (int j = 0; j < 8; ++j) *(LAS unsigned*)(dst + j * CPITCH) = pk2(o0[j], o1[j]);
            }
        }
        __syncthreads();
        f32x16 acc[2][2];
#pragma unroll
        for (int hh = 0; hh < 2; ++hh) {
            const int hd = g * 4 + hp * 2 + hh;
            const float* pv = states + ((size_t)unit * 8 + hd) * 8192;
#pragma unroll
            for (int pt = 0; pt < 2; ++pt) acc[hh][pt] = (f32x16){};
#pragma unroll
            for (int ks = 0; ks < 8; ++ks) {
                const bf16x8 cf = *(const LAS bf16x8*)(CM + l * CPITCH + ks * 16 + hi * 8);
#pragma unroll
                for (int pt = 0; pt < 2; ++pt) {
                    const float* pp = pv + (pt * 32 + r32) * 128 + ks * 16 + hi * 8;
                    const f32x4 p0 = *(const f32x4*)pp, p1 = *(const f32x4*)(pp + 4);
                    u32x4 w; w.x = pk2(p0[0], p0[1]); w.y = pk2(p0[2], p0[3]); w.z = pk2(p1[0], p1[1]); w.w = pk2(p1[2], p1[3]);
                    acc[hh][pt] = MFMA32(__builtin_bit_cast(bf16x8, w), cf, acc[hh][pt]);
                }
            }
            const float ea = __builtin_amdgcn_exp2f(acs[l * 8 + hd] * LOG2E);
#pragma unroll
            for (int pt = 0; pt < 2; ++pt)
#pragma unroll
                for (int j = 0; j < 16; ++j) acc[hh][pt][j] *= ea;
        }
        for (int st = 0; st <= lt; ++st) {
            f32x16 cbt = {};
#pragma unroll
            for (int ks = 0; ks < 8; ++ks) {
                const bf16x8 bf = *(const LAS bf16x8*)(BM + (st * 32 + r32) * CPITCH + ks * 16 + hi * 8);
                const bf16x8 cf = *(const LAS bf16x8*)(CM + l * CPITCH + ks * 16 + hi * 8);
                cbt = MFMA32(bf, cf, cbt);
            }
#pragma unroll
            for (int hh = 0; hh < 2; ++hh) {
                const int hd = g * 4 + hp * 2 + hh;
                const float al = acs[l * 8 + hd], dsk = a.in[16][layer * 8 + hd];
                float x[16];
#pragma unroll
                for (int j = 0; j < 16; ++j) { const int s = st * 32 + crow(j, hi);
                    const float e = __builtin_amdgcn_exp2f(fminf(al - acs[s * 8 + hd], 0.f) * LOG2E) * dtv[s * 8 + hd];
                    x[j] = (s <= l) ? cbt[j] * e : 0.f; if (s == l) x[j] += dsk; }
                u32x4 w0, w1;
                w0.x = pk2(x[0], x[1]); w0.y = pk2(x[2], x[3]); w0.z = pk2(x[4], x[5]); w0.w = pk2(x[6], x[7]);
                w1.x = pk2(x[8], x[9]); w1.y = pk2(x[10], x[11]); w1.z = pk2(x[12], x[13]); w1.w = pk2(x[14], x[15]);
                const bf16x8 xf0 = __builtin_bit_cast(bf16x8, w0), xf1 = __builtin_bit_cast(bf16x8, w1);
#pragma unroll
                for (int pt = 0; pt < 2; ++pt) {
                    const LAS bf16_t* xr = XS + ((hp * 2 + hh) * 64 + pt * 32 + r32) * CPITCH + st * 32 + 4 * hi;
                    const u32x2 a0 = *(const LAS u32x2*)(xr), a1 = *(const LAS u32x2*)(xr + 8), a2 = *(const LAS u32x2*)(xr + 16), a3 = *(const LAS u32x2*)(xr + 24);
                    const u32x4 f0 = {a0.x, a0.y, a1.x, a1.y}, f1 = {a2.x, a2.y, a3.x, a3.y};
                    acc[hh][pt] = MFMA32(__builtin_bit_cast(bf16x8, f0), xf0, acc[hh][pt]);
                    acc[hh][pt] = MFMA32(__builtin_bit_cast(bf16x8, f1), xf1, acc[hh][pt]);
                }
            }
        }
        float ssq = 0.f;
        const size_t orow = (rowbase + tc0 + l);
#pragma unroll
        for (int hh = 0; hh < 2; ++hh)
#pragma unroll
            for (int pt = 0; pt < 2; ++pt)
#pragma unroll
                for (int q = 0; q < 4; ++q) {
                    const int ch = g * 256 + (hp * 2 + hh) * 64 + pt * 32 + 8 * q + 4 * hi;
                    const u32x2 zz = *(const u32x2*)(proj + orow * NPROJ + C_Z + ch);
                    const float z0 = bflo(zz.x), z1 = bfhi(zz.x), z2 = bflo(zz.y), z3 = bfhi(zz.y);
                    const float y0 = acc[hh][pt][4 * q + 0] * z0 * fast_sigmoid(z0), y1 = acc[hh][pt][4 * q + 1] * z1 * fast_sigmoid(z1);
                    const float y2 = acc[hh][pt][4 * q + 2] * z2 * fast_sigmoid(z2), y3 = acc[hh][pt][4 * q + 3] * z3 * fast_sigmoid(z3);
                    ssq += (y0 * y0 + y1 * y1) + (y2 * y2 + y3 * y3);
                    u32x2 w; w.x = pk2(y0, y1); w.y = pk2(y2, y3);
                    *(u32x2*)(mixo + orow * DM + 512 + ch) = w;
                }
        ssq += __shfl_xor(ssq, 32);
        if (hi == 0) part[l * 4 + g * 2 + hp] = ssq;
        __syncthreads();
    }
    {
        const float* ng = a.in[17] + layer * 512;
        for (int it = tid; it < 128 * 64; it += NTHR) {
            const int row = it >> 6, cc = (it & 63) * 8;
            const float ss = (part[row * 4 + 0] + part[row * 4 + 1]) + (part[row * 4 + 2] + part[row * 4 + 3]);
            const float rinv = 1.0f / sqrtf(ss * (1.0f / 512.0f) + LN_EPS);
            bf16_t* p = mixo + (rowbase + tc0 + row) * DM + 512 + cc;
            const u32x4 t = *(const u32x4*)p; const f32x4 g0 = *(const f32x4*)(ng + cc), g1 = *(const f32x4*)(ng + cc + 4);
            u32x4 w;
            w.x = pk2(bflo(t.x) * rinv * g0[0], bfhi(t.x) * rinv * g0[1]); w.y = pk2(bflo(t.y) * rinv * g0[2], bfhi(t.y) * rinv * g0[3]);
            w.z = pk2(bflo(t.z) * rinv * g1[0], bfhi(t.z) * rinv * g1[1]); w.w = pk2(bflo(t.w) * rinv * g1[2], bfhi(t.w) * rinv * g1[3]);
            *(u32x4*)p = w;
        }
    }
    __syncthreads();
}

constexpr int KP = 72;
constexpr int L_KBUF = 0, L_VBUF = 2 * 64 * KP * 2;
__device__ __forceinline__ void attn_unit(const Frame& F, const Args& a, int layer, int b, int h, int qb) {
    const bf16_t* proj = (const bf16_t*)(F.ws + WS_PROJ); bf16_t* mixo = (bf16_t*)(F.ws + WS_MIXO);
    const int tid = F.tid, lane = F.lane, wid = F.wave, r32 = lane & 31, hi = lane >> 5;
    const size_t rowbase = (size_t)b * SEQ; const int q0 = qb * 256, qw0 = q0 + wid * 32, myq = qw0 + r32;
    LAS bf16_t* Kb = (LAS bf16_t*)(F.lds + L_KBUF); LAS bf16_t* Vb = (LAS bf16_t*)(F.lds + L_VBUF);
    bf16x8 qf[2][2];
    { const bf16_t* qp = proj + (rowbase + myq) * NPROJ + C_Q + h * 64 + hi * 8;
#pragma unroll
      for (int j = 0; j < 2; ++j)
#pragma unroll
        for (int ks = 0; ks < 2; ++ks) qf[j][ks] = *(const bf16x8*)(qp + j * 32 + ks * 16); }
    const float csc = 0.17677669529663687f * LOG2E;
    f32x16 o1[2], o2[2];
#pragma unroll
    for (int v = 0; v < 2; ++v) { o1[v] = (f32x16){}; o2[v] = (f32x16){}; }
    float m1 = -INFINITY, m2 = -INFINITY, l1 = 0.f, l2 = 0.f;
    const int NT = (q0 + 256) / 64;
    const bf16_t* kg = proj + (rowbase + (tid >> 3)) * NPROJ + C_K + h * 64 + (tid & 7) * 8;
    const bf16_t* vg = proj + (rowbase + lane) * NPROJ + C_V + h * 64 + wid * 8;
    LAS bf16_t* kdst = Kb + (tid >> 3) * KP + (tid & 7) * 8;
    LAS bf16_t* vdst = Vb + (wid * 8) * KP + lane;
    u32x4 kreg = *(const u32x4*)kg, vreg = *(const u32x4*)vg;
    __syncthreads();
    {
        *(LAS u32x4*)kdst = kreg;
        vdst[0 * KP] = (bf16_t)(vreg.x & 0xffffu); vdst[1 * KP] = (bf16_t)(vreg.x >> 16); vdst[2 * KP] = (bf16_t)(vreg.y & 0xffffu); vdst[3 * KP] = (bf16_t)(vreg.y >> 16);
        vdst[4 * KP] = (bf16_t)(vreg.z & 0xffffu); vdst[5 * KP] = (bf16_t)(vreg.z >> 16); vdst[6 * KP] = (bf16_t)(vreg.w & 0xffffu); vdst[7 * KP] = (bf16_t)(vreg.w >> 16);
    }
    __syncthreads();
    for (int t = 0; t < NT; ++t) {
        const int buf = t & 1;
        if (t + 1 < NT) { kreg = *(const u32x4*)(kg + (size_t)(t + 1) * 64 * NPROJ); vreg = *(const u32x4*)(vg + (size_t)(t + 1) * 64 * NPROJ); }
        const LAS bf16_t* Kt = Kb + buf * 64 * KP; const LAS bf16_t* Vt = Vb + buf * 64 * KP;
#pragma unroll
        for (int kb = 0; kb < 2; ++kb) {
            const int kbase = t * 64 + kb * 32;
            if (kbase <= qw0 + 31) {
                f32x16 s1 = {}, s2 = {};
#pragma unroll
                for (int ks = 0; ks < 2; ++ks) {
                    const bf16x8 k1 = *(const LAS bf16x8*)(Kt + (kb * 32 + r32) * KP + ks * 16 + hi * 8);
                    const bf16x8 k2 = *(const LAS bf16x8*)(Kt + (kb * 32 + r32) * KP + 32 + ks * 16 + hi * 8);
                    s1 = MFMA32(k1, qf[0][ks], s1); s2 = MFMA32(k2, qf[1][ks], s2);
                }
                if (kbase + 31 > qw0) {
#pragma unroll
                    for (int j = 0; j < 16; ++j) { const int key = kbase + crow(j, hi); if (key > myq) { s1[j] = -INFINITY; s2[j] = -INFINITY; } }
                }
                float mx1 = s1[0], mx2 = s2[0];
#pragma unroll
                for (int j = 1; j < 16; ++j) { mx1 = fmaxf(mx1, s1[j]); mx2 = fmaxf(mx2, s2[j]); }
                mx1 = fmaxf(mx1, __shfl_xor(mx1, 32)); mx2 = fmaxf(mx2, __shfl_xor(mx2, 32));
                const float mn1 = fmaxf(m1, mx1 * csc), mn2 = fmaxf(m2, mx2 * csc);
                const float al1 = __builtin_amdgcn_exp2f(m1 - mn1), al2 = __builtin_amdgcn_exp2f(m2 - mn2);
                m1 = mn1; m2 = mn2;
                float ps1 = 0.f, ps2 = 0.f;
#pragma unroll
                for (int j = 0; j < 16; ++j) { s1[j] = __builtin_amdgcn_exp2f(s1[j] * csc - mn1); s2[j] = __builtin_amdgcn_exp2f(s2[j] * csc - mn2); ps1 += s1[j]; ps2 += s2[j]; }
                l1 = l1 * al1 + ps1; l2 = l2 * al2 + ps2;
#pragma unroll
                for (int v = 0; v < 2; ++v)
#pragma unroll
                    for (int j = 0; j < 16; ++j) { o1[v][j] *= al1; o2[v][j] *= al2; }
                bf16x8 p1[2], p2[2];
#pragma unroll
                for (int ks = 0; ks < 2; ++ks) {
                    u32x4 w; w.x = pk2(s1[8 * ks + 0], s1[8 * ks + 1]); w.y = pk2(s1[8 * ks + 2], s1[8 * ks + 3]); w.z = pk2(s1[8 * ks + 4], s1[8 * ks + 5]); w.w = pk2(s1[8 * ks + 6], s1[8 * ks + 7]);
                    p1[ks] = __builtin_bit_cast(bf16x8, w);
                    u32x4 y; y.x = pk2(s2[8 * ks + 0], s2[8 * ks + 1]); y.y = pk2(s2[8 * ks + 2], s2[8 * ks + 3]); y.z = pk2(s2[8 * ks + 4], s2[8 * ks + 5]); y.w = pk2(s2[8 * ks + 6], s2[8 * ks + 7]);
                    p2[ks] = __builtin_bit_cast(bf16x8, y);
                }
#pragma unroll
                for (int v = 0; v < 2; ++v)
#pragma unroll
                    for (int ks = 0; ks < 2; ++ks) {
                        const LAS bf16_t* vp = Vt + (v * 32 + r32) * KP + kb * 32 + ks * 16 + 4 * hi;
                        const u32x2 a0 = *(const LAS u32x2*)vp, a1 = *(const LAS u32x2*)(vp + 8);
                        const u32x4 f = {a0.x, a0.y, a1.x, a1.y}; const bf16x8 vf = __builtin_bit_cast(bf16x8, f);
                        o1[v] = MFMA32(vf, p1[ks], o1[v]); o2[v] = MFMA32(vf, p2[ks], o2[v]);
                    }
            }
        }
        if (t + 1 < NT) {
            LAS bf16_t* kd = kdst + (buf ^ 1) * 64 * KP; LAS bf16_t* vd = vdst + (buf ^ 1) * 64 * KP;
            *(LAS u32x4*)kd = kreg;
            vd[0 * KP] = (bf16_t)(vreg.x & 0xffffu); vd[1 * KP] = (bf16_t)(vreg.x >> 16); vd[2 * KP] = (bf16_t)(vreg.y & 0xffffu); vd[3 * KP] = (bf16_t)(vreg.y >> 16);
            vd[4 * KP] = (bf16_t)(vreg.z & 0xffffu); vd[5 * KP] = (bf16_t)(vreg.z >> 16); vd[6 * KP] = (bf16_t)(vreg.w & 0xffffu); vd[7 * KP] = (bf16_t)(vreg.w >> 16);
        }
        __syncthreads();
    }
    float d1 = 0.f, d2 = 0.f;
#pragma unroll 8
    for (int i = 0; i < 32; ++i) { d1 += a.in[7][layer * 32 + i] * a.in[8][layer * 32 + i]; d2 += a.in[9][layer * 32 + i] * a.in[10][layer * 32 + i]; }
    const float lam_init = 0.8f - 0.6f * expf(-0.3f * (float)layer);
    const float lam = expf(d1) - expf(d2) + lam_init;
    l1 += __shfl_xor(l1, 32); l2 += __shfl_xor(l2, 32);
    const float i1 = 1.0f / l1, i2 = lam / l2;
    float ssq = 0.f;
#pragma unroll
    for (int v = 0; v < 2; ++v)
#pragma unroll
        for (int j = 0; j < 16; ++j) { const float o = o1[v][j] * i1 - o2[v][j] * i2; o1[v][j] = o; ssq += o * o; }
    ssq += __shfl_xor(ssq, 32);
    const float sc = (1.0f - lam_init) / sqrtf(ssq * (1.0f / 64.0f) + LN_EPS);
    const float* ng = a.in[11] + layer * 64;
    bf16_t* op = mixo + (rowbase + myq) * DM + 256 + h * 64;
#pragma unroll
    for (int v = 0; v < 2; ++v)
#pragma unroll
        for (int q = 0; q < 4; ++q) {
            const int vd = v * 32 + 8 * q + 4 * hi; const f32x4 g4 = *(const f32x4*)(ng + vd);
            u32x2 w; w.x = pk2(o1[v][4 * q + 0] * sc * g4[0], o1[v][4 * q + 1] * sc * g4[1]); w.y = pk2(o1[v][4 * q + 2] * sc * g4[2], o1[v][4 * q + 3] * sc * g4[3]);
            *(u32x2*)(op + vd) = w;
        }
}

#define RLX_AGENT __ATOMIC_RELAXED, __HIP_MEMORY_SCOPE_AGENT
#define XB_TMO      128
#define XB_XCNT(j)  (256  + 64 * (j))
#define XB_XSUB(j)  (1280 + 64 * (j))
#define XB_XGEN(j)  (2304 + 64 * (j))
#define XB_TOP      3328
#define XB_TOPGEN   3392
#define XCD_BAR_WORDS 3456
#define XB_SPIN_CAP (1u << 18)

__device__ __forceinline__ unsigned xb_ld(unsigned* p)              { return __hip_atomic_load(p, __ATOMIC_RELAXED, __HIP_MEMORY_SCOPE_AGENT); }
__device__ __forceinline__ unsigned xb_add(unsigned* p, unsigned v) { return __hip_atomic_fetch_add(p, v, __ATOMIC_RELAXED, __HIP_MEMORY_SCOPE_AGENT); }
__device__ __forceinline__ unsigned xb_xcc_id() { return (unsigned)__builtin_amdgcn_s_getreg((3 << 11) | 20) & 0xFu; }
#define XB_SPIN(cond, bar) do { unsigned _sp = 0; while (cond) { __builtin_amdgcn_s_sleep(1); \
    if ((++_sp & 255u) == 0u) { if (xb_ld(&(bar)[XB_TMO])) break; if (_sp > XB_SPIN_CAP) { atomicAdd(&(bar)[XB_TMO], 1u); break; } } } } while (0)

struct XcdBarrier {
    unsigned* bar; unsigned x;
    volatile LAS unsigned* st;
};

__device__ __forceinline__ XcdBarrier xcd_barrier_post(unsigned* bar, volatile LAS unsigned* st) {
    XcdBarrier b; b.bar = bar; b.x = xb_xcc_id(); b.st = st;
    if (threadIdx.x == 0) (void)xb_add(&bar[XB_XCNT(b.x)], 1u);
    return b;
}
__device__ __forceinline__ void xcd_barrier_complete(unsigned* bar, unsigned x, unsigned& nloc, unsigned& nx) {
    const unsigned G = gridDim.x * gridDim.y * gridDim.z;
    unsigned sum, cnt, mine, sp = 0u;
    for (;;) {
        sum = 0u; cnt = 0u; mine = 0u;
#pragma unroll
        for (unsigned j = 0; j < 16; ++j) { const unsigned c = xb_ld(&bar[XB_XCNT(j)]); sum += c; cnt += (c > 0u) ? 1u : 0u; mine = (j == x) ? c : mine; }
        if (sum == G) break;
        __builtin_amdgcn_s_sleep(1);
        if ((++sp & 255u) == 0u) { if (xb_ld(&bar[XB_TMO])) break; if (sp > XB_SPIN_CAP) { atomicAdd(&bar[XB_TMO], 1u); break; } }
    }
    nloc = mine > 0u ? mine : 1u; nx = cnt > 0u ? cnt : 1u;
}

__device__ __forceinline__ void xcd_barrier(const XcdBarrier& b) {
    asm volatile("s_waitcnt vmcnt(0)" ::: "memory");
    __syncthreads();
    if (threadIdx.x == 0) {
        unsigned* bar = b.bar;
        __builtin_amdgcn_s_waitcnt(0);
        unsigned nloc = b.st[0], nx = b.st[1];
        if (nloc == 0u) { xcd_barrier_complete(bar, b.x, nloc, nx); b.st[0] = nloc; b.st[1] = nx; }
        const unsigned old = xb_add(&bar[XB_XSUB(b.x)], 1u);
        const unsigned gen = old / nloc;
        if (old + 1u == (gen + 1u) * nloc) {
            __builtin_amdgcn_fence(__ATOMIC_RELEASE, "agent");
            asm volatile("s_waitcnt vmcnt(0)" ::: "memory");
            const unsigned og = xb_add(&bar[XB_TOP], 1u);
            const unsigned tg = og / nx;
            if (og + 1u == (tg + 1u) * nx) xb_add(&bar[XB_TOPGEN], 1u);
            else XB_SPIN(xb_ld(&bar[XB_TOPGEN]) == tg, bar);
            __builtin_amdgcn_fence(__ATOMIC_ACQUIRE, "agent");
            xb_add(&bar[XB_XGEN(b.x)], 1u);
            asm volatile("s_waitcnt vmcnt(0)" ::: "memory");
        } else {
            XB_SPIN(xb_ld(&bar[XB_XGEN(b.x)]) == gen, bar);
            __builtin_amdgcn_fence(__ATOMIC_ACQUIRE, "agent");
            asm volatile("s_waitcnt vmcnt(0)" ::: "memory");
        }
    }
    __syncthreads();
}

#ifndef MK_SPLIT
#define MK_SPLIT 0
#endif
constexpr int NPHASE = 1 + 9 * DEPTH;
__global__ void __launch_bounds__(NTHR, 2) fwd_megakernel(Args a) {
    extern __shared__ __attribute__((aligned(16))) unsigned char lds[];
    cg::grid_group grid = cg::this_grid();
    Frame F; F.probeN = 0;
    F.lds = (LAS unsigned char*)lds; F.ldsg = lds;
    F.tid = threadIdx.x; F.lane = F.tid & 63; F.wave = __builtin_amdgcn_readfirstlane(F.tid >> 6);
    F.G = gridDim.x; F.gw = blockIdx.x * NWAVES + F.wave; F.NGW = F.G * NWAVES; F.ws = a.ws;
    int vcu = (F.G % 8 == 0) ? ((int)blockIdx.x % 8) * (F.G / 8) + (int)blockIdx.x / 8 : (int)blockIdx.x;
    unsigned char* ws = a.ws;
    bf16_t* HB = (bf16_t*)(ws + WS_HB); bf16_t* PROJ = (bf16_t*)(ws + WS_PROJ); bf16_t* MIXO = (bf16_t*)(ws + WS_MIXO);
    bf16_t* FFA = (bf16_t*)(ws + WS_FFA); bf16_t* PG = (bf16_t*)(ws + WS_PG);
    float* STATS = (float*)(ws + WS_STATS); float* DTRAW = (float*)(ws + WS_DTRAW); const unsigned* WDT = (const unsigned*)(ws + WS_WDT);
#ifndef PHMASK
#define PHMASK 0x3ff
#endif
#define IN(k) (a.ph_lo <= (k) && (k) < a.ph_hi)
#define EN(i) ((PHMASK >> (i)) & 1)
#define FRESH() do { int t_ = threadIdx.x, b_ = blockIdx.x; asm volatile("" : "+v"(t_)); asm volatile("" : "+s"(b_)); F.tid = t_; F.lane = t_ & 63; F.wave = __builtin_amdgcn_readfirstlane(t_ >> 6); F.bid = b_; F.gw = b_ * NWAVES + F.wave; \
        vcu = (F.G % 8 == 0) ? (b_ % 8) * (F.G / 8) + b_ / 8 : b_; } while (0)
#ifndef PROBE_MASK
#define PROBE_MASK 0
#endif
#if PROBE_MASK
#define STAMP(i) do { if (blockIdx.x == 0 && threadIdx.x == 0) ((unsigned long long*)(ws + WS_TS))[i] = __builtin_amdgcn_s_memrealtime(); } while (0)
#else
#define STAMP(i) do {} while (0)
#endif
#define SEAM(k) do { if (IN(k) && IN((k) + 1)) { XcdBarrier xb_; xb_.bar = (unsigned*)(ws + WS_BAR); xb_.x = xb_xcc_id(); xb_.st = (volatile LAS unsigned*)(F.lds + LDS_MISC); xcd_barrier(xb_); } STAMP((k) + 1); } while (0)
    if (a.ph_lo < 0) grid.sync();
    if (threadIdx.x < 16) ((LAS unsigned*)(F.lds + LDS_MISC))[threadIdx.x] = 0u;
    __syncthreads();
    (void)xcd_barrier_post((unsigned*)(ws + WS_BAR), (volatile LAS unsigned*)(F.lds + LDS_MISC));
    STAMP(0);
    if (EN(0) && IN(0)) { FRESH(); p0_prologue(F, a); }
    SEAM(0);
    for (int layer = 0; layer < DEPTH; ++layer) {
        const int pb = 1 + 9 * layer;
        const unsigned char* wb = ws + WS_W + (size_t)layer * W_STRIDE;
        if (EN(1) && IN(pb + 0)) { FRESH();
            if (layer == 0) { dtraw_from_hb(F, HB, WDT, DTRAW); FRESH(); }
            pg8::Gemm g{HB, (const bf16_t*)(wb + W_IN), MTOK, NPROJ, DM}; pg8::StaticOrder S; S.init(MTOK, NPROJ, F.G, F.bid);
            EpiStoreBf16 E{PROJ, NPROJ};
            pg8::gemm_phase<EpiStoreBf16, pg8::StaticOrder, true, true>(F.lds, g, S, E, F.tid);
        }
        SEAM(pb + 0);
        if (EN(2) && IN(pb + 1)) { FRESH(); for (int u = F.bid; u < BATCH * NCHUNK; u += F.G) pool_c1_unit(F, a, layer, u); }
        SEAM(pb + 1);
        if (EN(3) && IN(pb + 2)) { FRESH(); scan_phase(F); }
        SEAM(pb + 2);
        if (EN(4) && IN(pb + 3)) { FRESH();
            for (int v = vcu; v < 256; v += F.G) { const int bh = v >> 4, s = v & 15;
                attn_unit(F, a, layer, bh >> 2, bh & 3, 31 - s);
                attn_unit(F, a, layer, bh >> 2, bh & 3, s); }
            STAMP(40 + layer);
            FRESH(); for (int u = F.bid; u < BATCH * NCHUNK; u += F.G) c3_unit(F, a, layer, u);
        }
        SEAM(pb + 3);
        if (EN(5) && IN(pb + 4)) { FRESH();
            { pg8::Gemm g{MIXO, (const bf16_t*)(wb + W_OUT), MTOK, DM, DM}; pg8::StaticOrder S; S.init(MTOK, DM, F.G, F.bid);
              EpiResid E{layer == 0 ? a.in[0] : (const float*)a.out, a.out, STATS, layer == 0 ? a.in[2] : a.in[25], layer == 0 ? a.in[3] : a.in[26], nullptr};
              pg8::gemm_phase<EpiResid, pg8::StaticOrder, true, true>(F.lds, g, S, E, F.tid); }
            FRESH();
            { pg8::Gemm g{(const bf16_t*)(ws + WS_PB) + (size_t)layer * MTOK * PLED, (const bf16_t*)(wb + W_PLE), MTOK, DM, PLED}; pg8::StaticOrder S; S.init(MTOK, DM, F.G, F.bid);
              EpiStoreBf16 E{PG, DM};
              pg8::gemm_phase<EpiStoreBf16, pg8::StaticOrder, true, true>(F.lds, g, S, E, F.tid); }
        }
        SEAM(pb + 4);
        if (EN(6) && IN(pb + 5)) { FRESH(); ln_rows<false, false>(F, a.out, a.in[19] + layer * DM, a.in[20] + layer * DM, HB, STATS, nullptr, nullptr, nullptr); }
        SEAM(pb + 5);
        if (EN(7) && IN(pb + 6)) { FRESH();
            pg8::Gemm g{HB, (const bf16_t*)(wb + W_FF1G), MTOK, DFF + DM, DM}; pg8::StaticOrder S; S.init(MTOK, DFF + DM, F.G, F.bid);
            EpiFf1Gate E{FFA, PG};
            pg8::gemm_phase<EpiFf1Gate, pg8::StaticOrder, true, true>(F.lds, g, S, E, F.tid);
        }
        SEAM(pb + 6);
        if (EN(8) && IN(pb + 7)) { FRESH();
            pg8::Gemm g{FFA, (const bf16_t*)(wb + W_FF2), MTOK, DM, DFF}; pg8::StaticOrder S; S.init(MTOK, DM, F.G, F.bid);
            EpiResid E{(const float*)a.out, a.out, STATS, a.in[19] + layer * DM, a.in[20] + layer * DM, PG};
            pg8::gemm_phase<EpiResid, pg8::StaticOrder, true, true>(F.lds, g, S, E, F.tid);
        }
#if PROBE_MASK
        if (layer == DEPTH - 1 && blockIdx.x == 0 && threadIdx.x == 0) {
            const unsigned long long* ts = (const unsigned long long*)(ws + WS_TS); unsigned long long now = __builtin_amdgcn_s_memrealtime(), tot = 0;
            for (int p = 0; p < NPHASE - 1; ++p) { const int cat = p == 0 ? 0 : 1 + (p - 1) % 9; const unsigned long long t1 = (p == NPHASE - 2) ? now : ts[p + 1];
                if ((PROBE_MASK >> cat) & 1) tot += t1 - ts[p];
                if (cat == 4 && ((PROBE_MASK >> 10) & 1)) tot += ts[40 + (p - 1) / 9] - ts[p]; }
            *(unsigned*)(ws + WS_TS + 1024) = (unsigned)(tot * 16 / 100);
        }
#endif
        SEAM(pb + 7);
        if (EN(9) && IN(pb + 8)) { FRESH();
            if (layer + 1 < DEPTH) ln_rows<false, true>(F, a.out, a.in[25] + layer * DM, a.in[26] + layer * DM, HB, STATS, WDT + (size_t)(layer + 1) * 8 * 512, DTRAW, nullptr);
            else {
#if PROBE_MASK
                F.probeN = *(const unsigned*)(ws + WS_TS + 1024);
#endif
                ln_rows<true, false>(F, a.out, a.in[25] + layer * DM, a.in[26] + layer * DM, nullptr, nullptr, nullptr, nullptr, a.out); }
        }
        if (layer + 1 < DEPTH) SEAM(pb + 8);
    }
#undef IN
#undef SEAM
}

extern "C" void kernel_launch(void* const* d_in, const int* in_sizes, int n_in, void* d_out, int out_size, void* d_ws, size_t ws_size, hipStream_t stream) {
    static int grid = 0;
    if (grid == 0) {
        if (n_in != 27 || out_size != MTOK * DM || ws_size < WS_END) { fprintf(stderr, "kernel_launch: unexpected shapes (n_in %d out %d ws %zu)\n", n_in, out_size, ws_size); grid = -1; return; }
        int dev = 0, cus = 0, per_cu = 0;
        (void)hipGetDevice(&dev); (void)hipDeviceGetAttribute(&cus, hipDeviceAttributeMultiprocessorCount, dev);
        if (hipFuncSetAttribute((const void*)fwd_megakernel, hipFuncAttributeMaxDynamicSharedMemorySize, LDS_BYTES) != hipSuccess) { fprintf(stderr, "kernel_launch: hipFuncSetAttribute failed\n"); grid = -1; return; }
        if (hipOccupancyMaxActiveBlocksPerMultiprocessor(&per_cu, (const void*)fwd_megakernel, NTHR, LDS_BYTES) != hipSuccess || per_cu < 1) per_cu = 1;
        (void)hipGetLastError();
        grid = cus * per_cu; if (grid > 256) grid = 256; if (grid < 1) grid = 1;
    }
    if (grid < 0) return;
    if (hipMemsetAsync((char*)d_ws + WS_BAR, 0, BAR_BYTES, stream) != hipSuccess) { fprintf(stderr, "kernel_launch: memset failed\n"); return; }
    Args a{};
    for (int i = 0; i < 27; ++i) a.in[i] = (const float*)d_in[i];
    a.out = (float*)d_out; a.ws = (unsigned char*)d_ws;
#if MK_SPLIT
    for (int ph = 0; ph < NPHASE; ++ph) { a.ph_lo = ph; a.ph_hi = ph + 1; void* args[] = {&a};
        hipError_t e = hipLaunchCooperativeKernel((const void*)fwd_megakernel, dim3(grid), dim3(NTHR), args, LDS_BYTES, stream);
        if (e != hipSuccess) { fprintf(stderr, "launch %d failed: %s\n", ph, hipGetErrorString(e)); break; } }
#else
    a.ph_lo = 0; a.ph_hi = NPHASE; void* args[] = {&a};
    hipError_t e = hipLaunchCooperativeKernel((const void*)fwd_megakernel, dim3(grid), dim3(NTHR), args, LDS_BYTES, stream);
    if (e != hipSuccess) fprintf(stderr, "cooperative launch failed: %s (grid %d)\n", hipGetErrorString(e), grid);
#endif
}
```

```cpp
#include <hip/hip_runtime.h>
#include <hip/hip_cooperative_groups.h>
#include <cstdio>
#include <cstdint>
namespace cg = cooperative_groups;
#define PROBE_MASK 0
namespace pg8 {
#define PG8_LAS __attribute__((address_space(3)))
typedef unsigned short bf16_t;
typedef short bf16x8 __attribute__((ext_vector_type(8)));
typedef float f32x4 __attribute__((ext_vector_type(4)));
typedef unsigned u32x4 __attribute__((ext_vector_type(4)));
constexpr int BM = 256, BK = 64, HALF = 128, HTB = HALF * BK * 2  , STAGE_BYTES = 8 * HTB, NXCD = 8, WGM = 8;

__host__ __device__ __forceinline__ int lds_byte(int r, int c) { const int st = (r >> 4) * 2 + (c >> 5), rr = r & 15, cc = c & 31, ob = rr * 64 + cc * 2; return st * 1024 + (ob ^ (((ob >> 9) & 1) << 5)); }
__host__ __device__ __forceinline__ void stage_rc(int b, int& R, int& C) { const int st = b / 1024, sb = b % 1024, swz = sb ^ (((sb >> 9) & 1) << 5); R = (st >> 1) * 16 + swz / 64; C = (st & 1) * 32 + (swz % 64) / 2; }
__host__ __device__ __forceinline__ int perm32(int rho) { const int n = rho >> 4, i = rho & 15; return 8 * (i >> 2) + 4 * n + (i & 3); }

struct Unit { int pm, pn; };
struct Gemm { const bf16_t* A; const bf16_t* Bt; int M, N, K; };

struct StaticOrder {
    int nM, nN, nwg, G, c;
    __host__ __device__ void init(int M, int N, int G_, int c_) { nM = M / BM; nN = N / BM; nwg = nM * nN; G = G_; c = c_; }
    __host__ __device__ bool next(int i, Unit& u) const {
        const long L = (long)i * G + c; if (L >= nwg) return false;
        int wgid = (int)L; { const int q = nwg / NXCD, r = nwg % NXCD, xcd = wgid % NXCD, off = wgid / NXCD; wgid = (xcd < r ? xcd * (q + 1) : r * (q + 1) + (xcd - r) * q) + off; }
        const int nig = WGM * nN, gid = wgid / nig, fm = gid * WGM, gsz = (nM - fm) < WGM ? (nM - fm) : WGM;
        u.pm = fm + ((wgid % nig) % gsz); u.pn = (wgid % nig) / gsz; return true;
    }
    __device__ __forceinline__ void a_ready(const Unit&) const {}
    __device__ __forceinline__ void done(const Unit&) const {}
};
__device__ __forceinline__ unsigned cvt_pk_bf16(float lo, float hi) { unsigned r; asm volatile("v_cvt_pk_bf16_f32 %0, %1, %2" : "=v"(r) : "v"(lo), "v"(hi)); return r; }
typedef float f32x2 __attribute__((ext_vector_type(2)));
template <class Epi, class Sched, bool ALIGN_EPI = false, bool SP2 = false>
__device__ __forceinline__ void gemm_phase(PG8_LAS unsigned char* lds, const Gemm g, const Sched& S, const Epi& E, const int tid_in) {
    const int tid = tid_in, wid = __builtin_amdgcn_readfirstlane(tid >> 6), lane = tid & 63, wr = wid >> 2, wc = wid & 3, fr = lane & 15, fq = lane >> 4;
    const int K = g.K, nt = K / BK;
    unsigned voffA[2], voffB[2];
#pragma unroll
    for (int i = 0; i < 2; ++i) { int R, C; stage_rc(tid * 16 + i * 8192, R, C); const int Rb = Epi::PERM ? ((R & ~31) + perm32(R & 31)) : R;
        voffA[i] = (unsigned)(R * K + C) * 2u; voffB[i] = (unsigned)(Rb * K + C) * 2u; }
    const size_t kstep = (size_t)(BK * 2);
    const size_t hstep = (size_t)HALF * K * 2;
    const size_t tstep = 2 * hstep;
    const unsigned ldsw = (unsigned)wid * 1024u;
    const int aoff = lds_byte(wr * 64 + fr, fq * 8), boff = lds_byte(wc * 32 + fr, fq * 8);
#define PG8_SA(b, h) (((b) * 2 + (h)) * HTB)
#define PG8_SB(b, h) ((4 + (b) * 2 + (h)) * HTB)
#define PG8_STAGE(bufoff, gbase, voff) do { _Pragma("unroll") for (int _i = 0; _i < 2; ++_i) \
        __builtin_amdgcn_global_load_lds((const unsigned*)((const char*)(gbase) + (voff)[_i]), (PG8_LAS unsigned*)(lds + (bufoff) + ldsw + _i * 8192), 16, 0, 0); } while (0)
#define PG8_LDA(dst, b, h) do { _Pragma("unroll") for (int m = 0; m < 4; ++m) _Pragma("unroll") for (int k = 0; k < 2; ++k) dst[m][k] = *(const PG8_LAS bf16x8*)(lds + PG8_SA(b, h) + aoff + m * 2048 + k * 1024); } while (0)
#define PG8_LDB(dst, b, h) do { _Pragma("unroll") for (int n = 0; n < 2; ++n) _Pragma("unroll") for (int k = 0; k < 2; ++k) dst[n][k] = *(const PG8_LAS bf16x8*)(lds + PG8_SB(b, h) + boff + n * 2048 + k * 1024); } while (0)
#define PG8_MMA(ai, bj, At, Bt) do { __builtin_amdgcn_s_setprio(1); _Pragma("unroll") for (int m = 0; m < 4; ++m) _Pragma("unroll") for (int n = 0; n < 2; ++n) _Pragma("unroll") for (int k = 0; k < 2; ++k) \
        acc[ai][bj][m][n] = __builtin_amdgcn_mfma_f32_16x16x32_bf16(Bt[n][k], At[m][k], acc[ai][bj][m][n], 0, 0, 0); __builtin_amdgcn_s_setprio(0); } while (0)
#define PG8_WAIT_V(n) asm volatile("s_waitcnt vmcnt(" #n ")" ::: "memory")
#define PG8_WAIT_L(n) asm volatile("s_waitcnt lgkmcnt(" #n ")" ::: "memory")
#define PG8_BAR __builtin_amdgcn_s_barrier()
#define PG8_SCHED __builtin_amdgcn_sched_barrier(0)
    Unit cur, nxt; int ui = 0;
    if (!S.next(0, cur)) return;
    f32x4 acc[2][2][4][2];
#pragma unroll
    for (int a = 0; a < 2; ++a)
#pragma unroll
        for (int b = 0; b < 2; ++b)
#pragma unroll
            for (int m = 0; m < 4; ++m)
#pragma unroll
                for (int n = 0; n < 2; ++n) acc[a][b][m][n] = (f32x4){0.f, 0.f, 0.f, 0.f};
    bf16x8 At[4][2], B0[2][2], B1[2][2];
    const char* cA = (const char*)g.A + (size_t)cur.pm * tstep; const char* cB = (const char*)g.Bt + (size_t)cur.pn * tstep;
    S.a_ready(cur);
    if constexpr (SP2) {
        PG8_STAGE(PG8_SB(0, 0), cB, voffB); PG8_STAGE(PG8_SB(0, 1), cB + hstep, voffB); PG8_STAGE(PG8_SA(0, 0), cA, voffA); PG8_STAGE(PG8_SA(0, 1), cA + hstep, voffA);
        if (wr == 1) PG8_BAR;
        PG8_WAIT_V(2); PG8_BAR;
        PG8_STAGE(PG8_SB(1, 0), cB + kstep, voffB); PG8_STAGE(PG8_SA(1, 0), cA + kstep, voffA); PG8_STAGE(PG8_SB(1, 1), cB + hstep + kstep, voffB);
        PG8_WAIT_V(6); PG8_BAR;
    } else {
        PG8_STAGE(PG8_SB(0, 0), cB, voffB); PG8_STAGE(PG8_SA(0, 0), cA, voffA); PG8_STAGE(PG8_SB(0, 1), cB + hstep, voffB); PG8_STAGE(PG8_SA(0, 1), cA + hstep, voffA);
        if (wr == 1) PG8_BAR;
        PG8_WAIT_V(4); PG8_BAR;
        PG8_STAGE(PG8_SB(1, 0), cB + kstep, voffB); PG8_STAGE(PG8_SA(1, 0), cA + kstep, voffA); PG8_STAGE(PG8_SB(1, 1), cB + hstep + kstep, voffB);
        PG8_WAIT_V(6); PG8_BAR;
    }
    for (;;) {
        const bool has_next = S.next(ui + 1, nxt);
        const char* nA = has_next ? (const char*)g.A + (size_t)nxt.pm * tstep : cA; const char* nB = has_next ? (const char*)g.Bt + (size_t)nxt.pn * tstep : cB;
        for (int t = 0; t < nt; t += 2) {
            const bool last = (t == nt - 2);
            const char* a1 = cA + (size_t)(t + 1) * kstep;
            const char* a2 = last ? nA : cA + (size_t)(t + 2) * kstep; const char* b2 = last ? nB : cB + (size_t)(t + 2) * kstep;
            const char* a3 = a2 + kstep; const char* b3 = b2 + kstep;
            if (last && has_next) S.a_ready(nxt);
            if constexpr (SP2) {
            PG8_LDB(B0, 0, 0); PG8_LDB(B1, 0, 1); PG8_SCHED; PG8_LDA(At, 0, 0); PG8_STAGE(PG8_SA(1, 1), a1 + hstep, voffA);
            PG8_WAIT_V(8); PG8_WAIT_L(0); PG8_BAR; PG8_MMA(0, 0, At, B0); PG8_MMA(0, 1, At, B1); PG8_BAR; PG8_SCHED;
            PG8_LDA(At, 0, 1); PG8_STAGE(PG8_SB(0, 0), b2, voffB); PG8_STAGE(PG8_SB(0, 1), b2 + hstep, voffB); PG8_STAGE(PG8_SA(0, 0), a2, voffA);
            PG8_WAIT_V(8); PG8_WAIT_L(0); PG8_BAR; PG8_MMA(1, 0, At, B0); PG8_MMA(1, 1, At, B1); PG8_BAR; PG8_SCHED;
            PG8_LDB(B0, 1, 0); PG8_LDB(B1, 1, 1); PG8_SCHED; PG8_LDA(At, 1, 0); PG8_STAGE(PG8_SA(0, 1), a2 + hstep, voffA);
            PG8_WAIT_V(8); PG8_WAIT_L(0); PG8_BAR; PG8_MMA(0, 0, At, B0); PG8_MMA(0, 1, At, B1); PG8_BAR; PG8_SCHED;
            PG8_LDA(At, 1, 1); PG8_STAGE(PG8_SB(1, 0), b3, voffB); PG8_STAGE(PG8_SB(1, 1), b3 + hstep, voffB); PG8_STAGE(PG8_SA(1, 0), a3, voffA);
            PG8_WAIT_V(8); PG8_WAIT_L(0); PG8_BAR; PG8_MMA(1, 0, At, B0); PG8_MMA(1, 1, At, B1); PG8_BAR; PG8_SCHED;
            } else {
            PG8_LDB(B0, 0, 0); PG8_SCHED; PG8_LDA(At, 0, 0); PG8_STAGE(PG8_SA(1, 1), a1 + hstep, voffA);
            PG8_WAIT_L(8); PG8_BAR; PG8_WAIT_L(0); PG8_MMA(0, 0, At, B0); PG8_BAR; PG8_SCHED;
            PG8_LDB(B1, 0, 1); PG8_STAGE(PG8_SB(0, 0), b2, voffB);
            PG8_BAR; PG8_WAIT_L(0); PG8_MMA(0, 1, At, B1); PG8_BAR;
            PG8_LDA(At, 0, 1); PG8_STAGE(PG8_SA(0, 0), a2, voffA);
            PG8_BAR; PG8_WAIT_L(0); PG8_MMA(1, 0, At, B0); PG8_BAR; PG8_SCHED;
            PG8_STAGE(PG8_SB(0, 1), b2 + hstep, voffB);
            PG8_WAIT_V(6); PG8_BAR; PG8_MMA(1, 1, At, B1); PG8_BAR;
            PG8_LDB(B0, 1, 0); PG8_SCHED; PG8_LDA(At, 1, 0); PG8_STAGE(PG8_SA(0, 1), a2 + hstep, voffA);
            PG8_WAIT_L(8); PG8_BAR; PG8_WAIT_L(0); PG8_MMA(0, 0, At, B0); PG8_BAR; PG8_SCHED;
            PG8_LDB(B1, 1, 1); PG8_STAGE(PG8_SB(1, 0), b3, voffB);
            PG8_BAR; PG8_WAIT_L(0); PG8_MMA(0, 1, At, B1); PG8_BAR;
            PG8_LDA(At, 1, 1); PG8_STAGE(PG8_SA(1, 0), a3, voffA);
            PG8_BAR; PG8_WAIT_L(0); PG8_MMA(1, 0, At, B0); PG8_BAR; PG8_SCHED;
            PG8_STAGE(PG8_SB(1, 1), b3 + hstep, voffB);
            PG8_WAIT_V(6); PG8_BAR; PG8_MMA(1, 1, At, B1); PG8_BAR;
            }
        }
        if constexpr (ALIGN_EPI) { if (wr == 0) PG8_BAR; }
        if constexpr (!Epi::AFTER_DRAIN) { int t2_ = threadIdx.x; asm volatile("" : "+v"(t2_)); const int w2_ = __builtin_amdgcn_readfirstlane(t2_ >> 6), l2_ = t2_ & 63;
            E(acc, cur, w2_ >> 2, w2_ & 3, l2_ & 15, l2_ >> 4); S.done(cur); }
        if (!has_next) break;
#pragma unroll
        for (int a = 0; a < 2; ++a)
#pragma unroll
            for (int b = 0; b < 2; ++b)
#pragma unroll
                for (int m = 0; m < 4; ++m)
#pragma unroll
                    for (int n = 0; n < 2; ++n) acc[a][b][m][n] = (f32x4){0.f, 0.f, 0.f, 0.f};
        cur = nxt; cA = nA; cB = nB; ++ui;
        if constexpr (ALIGN_EPI) { if (wr == 1) PG8_BAR; }
    }
    PG8_WAIT_V(0);
    if constexpr (!ALIGN_EPI) { if (wr == 0) PG8_BAR; }
    PG8_BAR;
    if constexpr (Epi::AFTER_DRAIN) { E.fused(acc, cur, wr, wc, fr, fq, lds, wid, lane); S.done(cur); }
#undef PG8_SA
#undef PG8_SB
#undef PG8_STAGE
#undef PG8_LDA
#undef PG8_LDB
#undef PG8_MMA
#undef PG8_WAIT_V
#undef PG8_WAIT_L
#undef PG8_BAR
#undef PG8_SCHED
}
}

#define LAS __attribute__((address_space(3)))
typedef unsigned short bf16_t;
typedef short bf16x8 __attribute__((ext_vector_type(8)));
typedef short s16x4 __attribute__((ext_vector_type(4)));
typedef float f32x2 __attribute__((ext_vector_type(2)));
typedef float f32x4 __attribute__((ext_vector_type(4)));
typedef float f32x16 __attribute__((ext_vector_type(16)));
typedef unsigned u32x2 __attribute__((ext_vector_type(2)));
typedef unsigned u32x4 __attribute__((ext_vector_type(4)));
#define MFMA32(a, b, c) __builtin_amdgcn_mfma_f32_32x32x16_bf16((a), (b), (c), 0, 0, 0)

constexpr int NWAVES = 8, NTHR = 512;
constexpr int BATCH = 4, SEQ = 8192, DM = 1024, MTOK = BATCH * SEQ, INW = 2568, NPROJ = 2560, DFF = 4096, PLED = 256, DEPTH = 2;
constexpr int C_POOL = 0, C_Q = 256, C_K = 512, C_V = 768, C_Z = 1024, C_XBC = 1536;
constexpr int NCHUNK = SEQ / 128;
constexpr float LN_EPS = 1e-5f;
constexpr float ALPHA = 1.41421356237309515f;
constexpr float LOG2E = 1.4426950408889634f;

constexpr size_t MiB = 1u << 20;
constexpr size_t WS_STATS = 0;
constexpr size_t WS_DTRAW = 1 * MiB;
constexpr size_t WS_WDT = 2 * MiB;
constexpr size_t WS_POOLW = 2 * MiB + 256 * 1024;
constexpr size_t WS_CDEC = 2 * MiB + 512 * 1024;
constexpr size_t WS_TS = 3 * MiB;
constexpr size_t WS_W = 4 * MiB, W_STRIDE = 26 * MiB;
constexpr size_t W_IN = 0, W_OUT = 5 * MiB, W_FF1G = 7 * MiB, W_FF2 = 17 * MiB, W_PLE = 25 * MiB;
constexpr size_t WS_HB = 56 * MiB;
constexpr size_t WS_PB = 120 * MiB;
constexpr size_t WS_FFA = 152 * MiB;
constexpr size_t WS_PROJ = 152 * MiB;
constexpr size_t WS_MIXO = 312 * MiB;
constexpr size_t WS_PG = 408 * MiB;
constexpr size_t WS_STATES = 408 * MiB;
constexpr size_t WS_END = 472 * MiB;
constexpr int LDS_MISC = 153600, LDS_BYTES = 153600 + 64;
constexpr size_t WS_BAR = 3 * MiB + 65536, BAR_BYTES = 16384, WS_KMAX = WS_BAR + 14336;
constexpr float QSCALE = 0.17677669529663687f * LOG2E;

__device__ __forceinline__ float bf2f(unsigned short u) { return __uint_as_float(((unsigned)u) << 16); }
__device__ __forceinline__ float bflo(unsigned u) { return __uint_as_float(u << 16); }
__device__ __forceinline__ float bfhi(unsigned u) { return __uint_as_float(u & 0xffff0000u); }
__device__ __forceinline__ unsigned pk2(float lo, float hi) { return pg8::cvt_pk_bf16(lo, hi); }
template <int M> __device__ __forceinline__ float swz_xor(float v) { return __int_as_float(__builtin_amdgcn_ds_swizzle(__float_as_int(v), (M << 10) | 0x1f)); }
__device__ __forceinline__ float xsum32(float v) { const auto r = __builtin_amdgcn_permlane32_swap(__float_as_uint(v), __float_as_uint(v), false, false); return __uint_as_float(r[0]) + __uint_as_float(r[1]); }
__device__ __forceinline__ float xsum16(float v) { const auto r = __builtin_amdgcn_permlane16_swap(__float_as_uint(v), __float_as_uint(v), false, false); return __uint_as_float(r[0]) + __uint_as_float(r[1]); }
__device__ __forceinline__ float xget32(float v, bool up) { const auto r = __builtin_amdgcn_permlane32_swap(__float_as_uint(v), __float_as_uint(v), false, false); return __uint_as_float(up ? r[0] : r[1]); }
__device__ __forceinline__ float wave_sum(float v) {
    v += swz_xor<1>(v); v += swz_xor<2>(v); v += swz_xor<4>(v); v += swz_xor<8>(v); v += swz_xor<16>(v);
    return xsum32(v);
}
__device__ __forceinline__ float fast_sigmoid(float x) { return __builtin_amdgcn_rcpf(1.0f + __builtin_amdgcn_exp2f(-x * LOG2E)); }
__device__ __forceinline__ int crow(int r, int hi) { return (r & 3) + 8 * (r >> 2) + 4 * hi; }

using pg8::Unit;
struct EpiStoreBf16 {
    static constexpr bool PERM = true, AFTER_DRAIN = false;
    bf16_t* O; int ldc;
    __device__ __forceinline__ void operator()(const f32x4 (&acc)[2][2][4][2], const Unit& u, int wr, int wc, int fr, int fq) const {
        const int row0 = u.pm * 256 + wr * 64 + fr, col0 = u.pn * 256 + wc * 32 + 8 * fq;
#pragma unroll
        for (int ai = 0; ai < 2; ++ai)
#pragma unroll
            for (int m = 0; m < 4; ++m) { bf16_t* rowp = O + (size_t)(row0 + ai * 128 + m * 16) * ldc + col0;
#pragma unroll
                for (int bj = 0; bj < 2; ++bj) { const f32x4 v0 = acc[ai][bj][m][0], v1 = acc[ai][bj][m][1];
                    u32x4 w; w.x = pk2(v0[0], v0[1]); w.y = pk2(v0[2], v0[3]); w.z = pk2(v1[0], v1[1]); w.w = pk2(v1[2], v1[3]);
                    *(u32x4*)(rowp + bj * 128) = w; } }
    }
};
struct EpiProj {
    static constexpr bool PERM = true, AFTER_DRAIN = false;
    bf16_t* O; unsigned* kmax;
    __device__ __forceinline__ void operator()(const f32x4 (&acc)[2][2][4][2], const Unit& u, int wr, int wc, int fr, int fq) const {
        const int row0 = u.pm * 256 + wr * 64 + fr, col0 = u.pn * 256 + wc * 32 + 8 * fq;
        const float sc = (u.pn == 1) ? QSCALE : 1.0f;
#pragma unroll
        for (int ai = 0; ai < 2; ++ai)
#pragma unroll
            for (int m = 0; m < 4; ++m) { bf16_t* rowp = O + (size_t)(row0 + ai * 128 + m * 16) * NPROJ + col0;
#pragma unroll
                for (int bj = 0; bj < 2; ++bj) { const f32x4 v0 = acc[ai][bj][m][0] * sc, v1 = acc[ai][bj][m][1] * sc;
                    u32x4 w; w.x = pk2(v0[0], v0[1]); w.y = pk2(v0[2], v0[3]); w.z = pk2(v1[0], v1[1]); w.w = pk2(v1[2], v1[3]);
                    *(u32x4*)(rowp + bj * 128) = w; } }
        if (u.pn == 2) {
#pragma unroll
            for (int bj = 0; bj < 2; ++bj) { float mx = 0.f;
#pragma unroll
                for (int ai = 0; ai < 2; ++ai)
#pragma unroll
                    for (int m = 0; m < 4; ++m) { const f32x4 v0 = acc[ai][bj][m][0], v1 = acc[ai][bj][m][1];
                        float ss = (v0[0] * v0[0] + v0[1] * v0[1]) + (v0[2] * v0[2] + v0[3] * v0[3]) + (v1[0] * v1[0] + v1[1] * v1[1]) + (v1[2] * v1[2] + v1[3] * v1[3]);
                        ss = xsum16(ss); ss = xsum32(ss); mx = fmaxf(mx, ss); }
                mx = fmaxf(mx, swz_xor<1>(mx)); mx = fmaxf(mx, swz_xor<2>(mx)); mx = fmaxf(mx, swz_xor<4>(mx)); mx = fmaxf(mx, swz_xor<8>(mx));
                if (fr == 0 && fq == 0) atomicMax(kmax + (u.pm >> 5) * 8 + bj * 4 + wc, __float_as_uint(mx)); }
        }
    }
};
struct EpiFf1Gate {
    static constexpr bool PERM = true, AFTER_DRAIN = false;
    bf16_t* FFA; bf16_t* PG;
    __device__ __forceinline__ void operator()(const f32x4 (&acc)[2][2][4][2], const Unit& u, int wr, int wc, int fr, int fq) const {
        const int row0 = u.pm * 256 + wr * 64 + fr;
        if (u.pn < 16) {
            const int col0 = u.pn * 256 + wc * 32 + 8 * fq;
#pragma unroll
            for (int ai = 0; ai < 2; ++ai)
#pragma unroll
                for (int m = 0; m < 4; ++m) { bf16_t* rowp = FFA + (size_t)(row0 + ai * 128 + m * 16) * DFF + col0;
#pragma unroll
                    for (int bj = 0; bj < 2; ++bj) { f32x4 v0 = acc[ai][bj][m][0], v1 = acc[ai][bj][m][1];
#pragma unroll
                        for (int e = 0; e < 4; ++e) { const float a = fmaxf(v0[e], 0.f), b = fmaxf(v1[e], 0.f); v0[e] = a * a; v1[e] = b * b; }
                        u32x4 w; w.x = pk2(v0[0], v0[1]); w.y = pk2(v0[2], v0[3]); w.z = pk2(v1[0], v1[1]); w.w = pk2(v1[2], v1[3]);
                        *(u32x4*)(rowp + bj * 128) = w; } }
        } else {
            const int col0 = (u.pn - 16) * 256 + wc * 32 + 8 * fq;
#pragma unroll
            for (int ai = 0; ai < 2; ++ai)
#pragma unroll
                for (int m = 0; m < 4; ++m) { bf16_t* rowp = PG + (size_t)(row0 + ai * 128 + m * 16) * DM + col0;
#pragma unroll
                    for (int bj = 0; bj < 2; ++bj) { const f32x4 v0 = acc[ai][bj][m][0], v1 = acc[ai][bj][m][1];
                        const u32x4 t = *(const u32x4*)(rowp + bj * 128);
                        u32x4 w;
                        w.x = pk2(bflo(t.x) * fast_sigmoid(v0[0]), bfhi(t.x) * fast_sigmoid(v0[1]));
                        w.y = pk2(bflo(t.y) * fast_sigmoid(v0[2]), bfhi(t.y) * fast_sigmoid(v0[3]));
                        w.z = pk2(bflo(t.z) * fast_sigmoid(v1[0]), bfhi(t.z) * fast_sigmoid(v1[1]));
                        w.w = pk2(bflo(t.w) * fast_sigmoid(v1[2]), bfhi(t.w) * fast_sigmoid(v1[3]));
                        *(u32x4*)(rowp + bj * 128) = w; } }
        }
    }
};
struct EpiResid {
    static constexpr bool PERM = false, AFTER_DRAIN = false;
    const float* src; float* dst; const float* stats; const float* gam; const float* bet; const bf16_t* PG;
    __device__ __forceinline__ void operator()(const f32x4 (&acc)[2][2][4][2], const Unit& u, int wr, int wc, int fr, int fq) const {
        const int row0 = u.pm * 256 + wr * 64 + fr;
        f32x2 st[2][4];
#pragma unroll
        for (int ai = 0; ai < 2; ++ai)
#pragma unroll
            for (int m = 0; m < 4; ++m) st[ai][m] = *(const f32x2*)(stats + 2 * (unsigned)(row0 + ai * 128 + m * 16));
#pragma unroll
        for (int bj = 0; bj < 2; ++bj)
#pragma unroll
            for (int n = 0; n < 2; ++n) {
                const int col = u.pn * 256 + bj * 128 + wc * 32 + n * 16 + 4 * fq;
                const f32x4 g4 = *(const f32x4*)(gam + col), b4 = *(const f32x4*)(bet + col);
#pragma unroll
                for (int ai = 0; ai < 2; ++ai)
#pragma unroll
                    for (int m = 0; m < 4; ++m) {
                        const unsigned off = (unsigned)(row0 + ai * 128 + m * 16) * DM + col;
                        const f32x4 x4 = *(const f32x4*)(src + off);
                        f32x4 o = ((x4 - st[ai][m].x) * st[ai][m].y * g4 + b4) * ALPHA + acc[ai][bj][m][n];
                        if (PG) { const u32x2 t = *(const u32x2*)(PG + off); o[0] += bflo(t.x); o[1] += bfhi(t.x); o[2] += bflo(t.y); o[3] += bfhi(t.y); }
                        *(f32x4*)(dst + off) = o;
                    }
            }
    }
};

struct Args { const float* in[27]; float* out; unsigned char* ws; int ph_lo, ph_hi; };
struct Frame {
    LAS unsigned char* lds; unsigned char* ldsg;
    int tid, lane, wave, G, gw, NGW, bid; unsigned probeN;
    unsigned char* ws;
};

__device__ __forceinline__ void transpose_item(const float* W, int ldw, int K, int nblk, bf16_t* WT, int row_off, LAS float* scr, int item, int lane) {
    const int kb = item / nblk, nb = item % nblk, k0 = 64 * kb, n0 = 32 * nb;
#pragma unroll 8
    for (int i = 0; i < 32; ++i) { const int kk = 2 * i + (lane >> 5); scr[kk * 33 + (lane & 31)] = W[(size_t)(k0 + kk) * ldw + n0 + (lane & 31)]; }
    asm volatile("s_waitcnt lgkmcnt(0)" ::: "memory");
    const int c = lane & 7;
#pragma unroll
    for (int j = 0; j < 4; ++j) { const int n = (lane >> 3) + 8 * j; const LAS float* s = scr + (8 * c) * 33 + n;
        u32x4 o; o.x = pk2(s[0 * 33], s[1 * 33]); o.y = pk2(s[2 * 33], s[3 * 33]); o.z = pk2(s[4 * 33], s[5 * 33]); o.w = pk2(s[6 * 33], s[7 * 33]);
        *(u32x4*)(WT + (size_t)(row_off + n0 + n) * K + k0 + 8 * c) = o; }
    asm volatile("s_waitcnt lgkmcnt(0)" ::: "memory");
}
typedef __bf16 bf16x2_t __attribute__((ext_vector_type(2)));
__device__ __forceinline__ float dot2bf(unsigned a, unsigned b, float c) { return __builtin_amdgcn_fdot2_f32_bf16(__builtin_bit_cast(bf16x2_t, a), __builtin_bit_cast(bf16x2_t, b), c, false); }
__device__ __forceinline__ float reduce8(const float (&d)[8], int lane) {
    float a[4];
    { const bool up = (lane & 32) != 0;
#pragma unroll
      for (int i = 0; i < 4; ++i) { const float keep = up ? d[4 + i] : d[i], send = up ? d[i] : d[4 + i]; a[i] = keep + xget32(send, up); } }
    float b[2];
    { const bool up = (lane & 16) != 0;
#pragma unroll
      for (int i = 0; i < 2; ++i) { const float keep = up ? a[2 + i] : a[i], send = up ? a[i] : a[2 + i]; b[i] = keep + swz_xor<16>(send); } }
    float c;
    { const bool up = (lane & 8) != 0; const float keep = up ? b[1] : b[0], send = up ? b[0] : b[1]; c = keep + swz_xor<8>(send); }
    c += swz_xor<4>(c); c += swz_xor<2>(c); c += swz_xor<1>(c);
    return c;
}
template <bool FINAL, bool DT>
__device__ __forceinline__ void ln_rows(const Frame& F, const float* src, const float* gam, const float* bet, bf16_t* hb, float* stats, const unsigned* wdtp, float* dtraw, float* fout) {
    f32x4 g[4], b[4];
#pragma unroll
    for (int j = 0; j < 4; ++j) { g[j] = *(const f32x4*)(gam + 4 * F.lane + 256 * j); b[j] = *(const f32x4*)(bet + 4 * F.lane + 256 * j); }
    u32x2 wd[8][4];
    if (DT) {
#pragma unroll
        for (int h = 0; h < 8; ++h)
#pragma unroll
            for (int j = 0; j < 4; ++j) wd[h][j] = *(const u32x2*)(wdtp + h * 512 + 128 * j + 2 * F.lane);
    }
    const int lane = F.lane, NGW = F.NGW; const unsigned probeN = F.probeN;
    auto ldrow = [&](f32x4 (&v)[4], int row) __attribute__((always_inline)) {
        if (row < MTOK) { const float* xr = src + (size_t)row * DM + 4 * lane;
#pragma unroll
            for (int j = 0; j < 4; ++j) v[j] = *(const f32x4*)(xr + 256 * j); } };
    auto proc = [&](f32x4 (&v)[4], int row) __attribute__((always_inline)) {
        if (row >= MTOK) return;
        float s = 0.f;
#pragma unroll
        for (int j = 0; j < 4; ++j) s += (v[j][0] + v[j][1]) + (v[j][2] + v[j][3]);
        const float mean = wave_sum(s) * (1.f / DM); float s2 = 0.f;
#pragma unroll
        for (int j = 0; j < 4; ++j) { v[j] = v[j] - mean; s2 += (v[j][0] * v[j][0] + v[j][1] * v[j][1]) + (v[j][2] * v[j][2] + v[j][3] * v[j][3]); }
        const float rstd = 1.0f / sqrtf(wave_sum(s2) * (1.f / DM) + LN_EPS);
#pragma unroll
        for (int j = 0; j < 4; ++j) v[j] = v[j] * rstd * g[j] + b[j];
        if (FINAL) {
#if PROBE_MASK
#pragma unroll
            for (int j = 0; j < 4; ++j)
#pragma unroll
                for (int e = 0; e < 4; ++e) if ((unsigned)(row * DM + 4 * lane + 256 * j + e) < probeN) v[j][e] += 0.125f;
#endif
#pragma unroll
            for (int j = 0; j < 4; ++j) *(f32x4*)(fout + (size_t)row * DM + 4 * lane + 256 * j) = v[j];
        } else {
            if (lane == 0) *(f32x2*)(stats + 2 * (size_t)row) = (f32x2){mean, rstd};
            u32x2 w[4];
#pragma unroll
            for (int j = 0; j < 4; ++j) { w[j].x = pk2(v[j][0], v[j][1]); w[j].y = pk2(v[j][2], v[j][3]); *(u32x2*)(hb + (size_t)row * DM + 4 * lane + 256 * j) = w[j]; }
            if (DT) {
                float d[8];
#pragma unroll
                for (int h = 0; h < 8; ++h) { float acc = 0.f;
#pragma unroll
                    for (int j = 0; j < 4; ++j) { acc = dot2bf(w[j].x, wd[h][j].x, acc); acc = dot2bf(w[j].y, wd[h][j].y, acc); }
                    d[h] = acc; }
                const float tot = reduce8(d, lane);
                if ((lane & 7) == 0) dtraw[(size_t)row * 8 + (lane >> 3)] = tot;
            }
        }
    };
    f32x4 v0[4], v1[4], v2[4], v3[4];
    int row = F.gw;
    ldrow(v0, row); ldrow(v1, row + NGW); ldrow(v2, row + 2 * NGW); ldrow(v3, row + 3 * NGW);
    for (; row < MTOK; row += 4 * NGW) {
        proc(v0, row);           ldrow(v0, row + 4 * NGW);
        proc(v1, row + NGW);     ldrow(v1, row + 5 * NGW);
        proc(v2, row + 2 * NGW); ldrow(v2, row + 6 * NGW);
        proc(v3, row + 3 * NGW); ldrow(v3, row + 7 * NGW);
    }
}
__device__ __forceinline__ void p0_prologue(const Frame& F, const Args& a) {
    LAS float* scr = (LAS float*)(F.lds + F.wave * 8704);
    unsigned char* ws = F.ws;
    constexpr int I_IN = 16 * 80, I_OUT = 16 * 32, I_FF1 = 16 * 128, I_G = 16 * 32, I_FF2 = 64 * 32, I_PLE = 4 * 32, I_L = I_IN + I_OUT + I_FF1 + I_G + I_FF2 + I_PLE;
    for (int it = F.gw; it < DEPTH * I_L; it += F.NGW) {
        const int l = it / I_L; int r = it % I_L;
        unsigned char* wb = ws + WS_W + (size_t)l * W_STRIDE;
        if (r < I_IN) { transpose_item(a.in[4] + (size_t)l * DM * INW, INW, DM, 80, (bf16_t*)(wb + W_IN), 0, scr, r, F.lane); continue; } r -= I_IN;
        if (r < I_OUT) { transpose_item(a.in[18] + (size_t)l * DM * DM, DM, DM, 32, (bf16_t*)(wb + W_OUT), 0, scr, r, F.lane); continue; } r -= I_OUT;
        if (r < I_FF1) { transpose_item(a.in[21] + (size_t)l * DM * DFF, DFF, DM, 128, (bf16_t*)(wb + W_FF1G), 0, scr, r, F.lane); continue; } r -= I_FF1;
        if (r < I_G) { transpose_item(a.in[24] + (size_t)l * DM * DM, DM, DM, 32, (bf16_t*)(wb + W_FF1G), DFF, scr, r, F.lane); continue; } r -= I_G;
        if (r < I_FF2) { transpose_item(a.in[22] + (size_t)l * DFF * DM, DM, DFF, 32, (bf16_t*)(wb + W_FF2), 0, scr, r, F.lane); continue; } r -= I_FF2;
        transpose_item(a.in[23] + (size_t)l * PLED * DM, DM, PLED, 32, (bf16_t*)(wb + W_PLE), 0, scr, r, F.lane);
    }
    const int gt = F.bid * NTHR + F.tid, NT = F.G * NTHR;
    {
        const float* p = a.in[1]; bf16_t* pb = (bf16_t*)(ws + WS_PB);
        for (size_t i = gt; i < (size_t)DEPTH * MTOK * PLED / 8; i += NT) { const f32x4 x0 = *(const f32x4*)(p + 8 * i), x1 = *(const f32x4*)(p + 8 * i + 4);
            u32x4 w; w.x = pk2(x0[0], x0[1]); w.y = pk2(x0[2], x0[3]); w.z = pk2(x1[0], x1[1]); w.w = pk2(x1[2], x1[3]); *(u32x4*)(pb + 8 * i) = w; }
    }
    {
        unsigned* wdt = (unsigned*)(ws + WS_WDT); bf16_t* pw = (bf16_t*)(ws + WS_POOLW);
        for (int i = gt; i < DEPTH * 8 * 512; i += NT) { const int l = i >> 12, j = (i >> 9) & 7, k = 2 * (i & 511); wdt[i] = pk2(a.in[4][((size_t)l * DM + k) * INW + NPROJ + j], a.in[4][((size_t)l * DM + k + 1) * INW + NPROJ + j]); }
        for (int i = gt; i < DEPTH * 4 * 64 * 64; i += NT) { const int lg = i >> 12, d = (i >> 6) & 63, c = i & 63; pw[i] = (bf16_t)(pk2(a.in[5][(size_t)lg * 4096 + c * 64 + d], 0.f) & 0xffffu); }
    }
    ln_rows<false, false>(F, a.in[0], a.in[2], a.in[3], (bf16_t*)(ws + WS_HB), (float*)(ws + WS_STATS), nullptr, nullptr, nullptr);
}
__device__ __forceinline__ void dtraw_from_hb(const Frame& F, const bf16_t* hb, const unsigned* wdtp, float* dtraw) {
    u32x2 wd[8][4];
#pragma unroll
    for (int h = 0; h < 8; ++h)
#pragma unroll
        for (int j = 0; j < 4; ++j) wd[h][j] = *(const u32x2*)(wdtp + h * 512 + 128 * j + 2 * F.lane);
    for (int row0 = F.gw; row0 < MTOK; row0 += 4 * F.NGW) {
        u32x2 w[4][4];
#pragma unroll
        for (int r = 0; r < 4; ++r) { const int row = row0 + r * F.NGW; if (row < MTOK) {
#pragma unroll
            for (int j = 0; j < 4; ++j) w[r][j] = *(const u32x2*)(hb + (size_t)row * DM + 4 * F.lane + 256 * j); } }
#pragma unroll
        for (int r = 0; r < 4; ++r) { const int row = row0 + r * F.NGW; if (row < MTOK) {
            float d[8];
#pragma unroll
            for (int h = 0; h < 8; ++h) { float acc = 0.f;
#pragma unroll
                for (int j = 0; j < 4; ++j) { acc = dot2bf(w[r][j].x, wd[h][j].x, acc); acc = dot2bf(w[r][j].y, wd[h][j].y, acc); }
                d[h] = acc; }
            const float tot = reduce8(d, F.lane);
            if ((F.lane & 7) == 0) dtraw[(size_t)row * 8 + (F.lane >> 3)] = tot; } }
    }
}

constexpr int L_TAB_DT = 143360, L_TAB_ACS = 147456, L_TAB_PART = 151552;
constexpr int CPITCH = 136;
__device__ __forceinline__ void ssd_tables(const Frame& F, const float* dtraw, const float* dt_bias, const float* a_log, int row0) {
    LAS float* dtv = (LAS float*)(F.lds + L_TAB_DT); LAS float* acs = (LAS float*)(F.lds + L_TAB_ACS);
    const int hd = F.wave, l0 = 2 * F.lane;
    const float bias = dt_bias[hd], A = -expf(a_log[hd]);
    const float x0 = dtraw[(size_t)(row0 + l0) * 8 + hd] + bias, x1 = dtraw[(size_t)(row0 + l0 + 1) * 8 + hd] + bias;
    const float d0 = fmaxf(x0, 0.f) + log1pf(expf(-fabsf(x0))), d1 = fmaxf(x1, 0.f) + log1pf(expf(-fabsf(x1)));
    const float a0 = d0 * A, a1 = d1 * A;
    float s = a0 + a1;
#pragma unroll
    for (int o = 1; o < 64; o <<= 1) { const float t = __int_as_float(__builtin_amdgcn_ds_bpermute((F.lane - o) << 2, __float_as_int(s))); if (F.lane >= o) s += t; }
    dtv[l0 * 8 + hd] = d0; dtv[(l0 + 1) * 8 + hd] = d1; acs[l0 * 8 + hd] = s - a1; acs[(l0 + 1) * 8 + hd] = s;
}
__device__ __forceinline__ void conv8(const bf16_t* proj, const float* cw, const float* cb, size_t rowbase, int t0, int cch, float (&o0)[8], float (&o1)[8]) {
    float xl[11], xh[11];
#pragma unroll
    for (int i = 0; i < 11; ++i) { const int t = t0 - 3 + i; unsigned v = 0u; if (t >= 0) v = *(const unsigned*)(proj + (rowbase + t) * NPROJ + C_XBC + cch); xl[i] = bflo(v); xh[i] = bfhi(v); }
    float w0[4], w1[4];
#pragma unroll
    for (int k = 0; k < 4; ++k) { const f32x2 w = *(const f32x2*)(cw + k * 1024 + cch); w0[k] = w.x; w1[k] = w.y; }
    const f32x2 bb = *(const f32x2*)(cb + cch);
#pragma unroll
    for (int j = 0; j < 8; ++j) {
        float y0 = bb.x, y1 = bb.y;
#pragma unroll
        for (int k = 0; k < 4; ++k) { y0 += w0[k] * xl[j + k]; y1 += w1[k] * xh[j + k]; }
        o0[j] = y0 * fast_sigmoid(y0); o1[j] = y1 * fast_sigmoid(y1);
    }
}

__device__ __forceinline__ void pool_c1_unit(const Frame& F, const Args& a, int layer, int unit) {
    const int b = unit / NCHUNK, c = unit % NCHUNK; const size_t rowbase = (size_t)b * SEQ; const int tc0 = c * 128;
    const bf16_t* proj = (const bf16_t*)(F.ws + WS_PROJ); bf16_t* mixo = (bf16_t*)(F.ws + WS_MIXO);
    const int tid = F.tid, lane = F.lane, wid = F.wave, r32 = lane & 31, hi = lane >> 5;
    {
        constexpr int PP = 264;
        LAS bf16_t* Pl = (LAS bf16_t*)F.lds;
        const int cp = tid & 127, sg = tid >> 7, gi = cp >> 5, w = 2 << gi;
        const bf16_t* up = proj + rowbase * NPROJ + C_POOL + 2 * cp;
        const int t0 = tc0 + sg * 32;
        float s0 = 0.f, s1 = 0.f;
        for (int i = 1; i < w; ++i) { const int t = t0 - i; if (t >= 0) { const unsigned v = *(const unsigned*)(up + (size_t)t * NPROJ); s0 += bflo(v); s1 += bfhi(v); } }
        for (int j = 0; j < 32; ++j) {
            const int t = t0 + j; const unsigned v = *(const unsigned*)(up + (size_t)t * NPROJ); const float u0 = bflo(v), u1 = bfhi(v);
            s0 += u0; s1 += u1;
            const float inv = 1.0f / (float)min(t + 1, w);
            *(LAS unsigned*)(Pl + (sg * 32 + j) * PP + 2 * cp) = pk2(s0 * inv - u0, s1 * inv - u1);
            const int tl = t - w + 1; if (tl >= 0) { const unsigned q = *(const unsigned*)(up + (size_t)tl * NPROJ); s0 -= bflo(q); s1 -= bfhi(q); }
        }
        __syncthreads();
        const int gw4 = wid >> 1, dt = wid & 1;
        const bf16_t* pw = (const bf16_t*)(F.ws + WS_POOLW) + ((size_t)(layer * 4 + gw4) * 64 + dt * 32 + r32) * 64;
        bf16x8 bfr[4];
#pragma unroll
        for (int ks = 0; ks < 4; ++ks) bfr[ks] = *(const bf16x8*)(pw + ks * 16 + hi * 8);
        const float sc = a.in[6][layer * 256 + gw4 * 64 + dt * 32 + r32];
#pragma unroll
        for (int tt = 0; tt < 4; ++tt) {
            f32x16 acc = {};
#pragma unroll
            for (int ks = 0; ks < 4; ++ks) { const bf16x8 af = *(const LAS bf16x8*)(Pl + (tt * 32 + r32) * PP + gw4 * 64 + ks * 16 + hi * 8); acc = MFMA32(af, bfr[ks], acc); }
            bf16_t* op = mixo + (rowbase + tc0 + tt * 32) * DM + C_POOL + gw4 * 64 + dt * 32 + r32;
#pragma unroll
            for (int j = 0; j < 16; ++j) op[(size_t)crow(j, hi) * DM] = (bf16_t)(pk2(acc[j] * sc, 0.f) & 0xffffu);
        }
        __syncthreads();
    }
    const float* dtraw = (const float*)(F.ws + WS_DTRAW);
    ssd_tables(F, dtraw, a.in[14] + layer * 8, a.in[15] + layer * 8, (int)rowbase + tc0);
    __syncthreads();
    LAS float* dtv = (LAS float*)(F.lds + L_TAB_DT); LAS float* acs = (LAS float*)(F.lds + L_TAB_ACS);
    const float* cw = a.in[12] + (size_t)layer * 4 * 1024; const float* cb = a.in[13] + (size_t)layer * 1024;
    LAS bf16_t* XS = (LAS bf16_t*)F.lds;
    LAS bf16_t* BT = (LAS bf16_t*)(F.lds + 256 * CPITCH * 2);
    float* states = (float*)(F.ws + WS_STATES);
    if (tid < 8) ((float*)(F.ws + WS_CDEC))[(size_t)unit * 8 + tid] = expf(acs[127 * 8 + tid]);
    for (int g = 0; g < 2; ++g) {
        for (int it = tid; it < 192 * 16; it += NTHR) {
            const int cpi = it % 192, oct = it / 192;
            const bool isx = cpi < 128;
            const int chl = isx ? 2 * cpi : 2 * (cpi - 128);
            const int cch = isx ? g * 256 + chl : 512 + g * 128 + chl;
            float o0[8], o1[8];
            conv8(proj, cw, cb, rowbase, tc0 + oct * 8, cch, o0, o1);
            if (isx) { const int hd = g * 4 + (chl >> 6); const float al = acs[127 * 8 + hd];
#pragma unroll
                for (int j = 0; j < 8; ++j) { const int l = oct * 8 + j; const float sc = dtv[l * 8 + hd] * __builtin_amdgcn_exp2f((al - acs[l * 8 + hd]) * LOG2E); o0[j] *= sc; o1[j] *= sc; } }
            LAS bf16_t* dst = (isx ? XS : BT) + chl * CPITCH + oct * 8;
            u32x4 w0, w1;
            w0.x = pk2(o0[0], o0[1]); w0.y = pk2(o0[2], o0[3]); w0.z = pk2(o0[4], o0[5]); w0.w = pk2(o0[6], o0[7]);
            w1.x = pk2(o1[0], o1[1]); w1.y = pk2(o1[2], o1[3]); w1.z = pk2(o1[4], o1[5]); w1.w = pk2(o1[6], o1[7]);
            *(LAS u32x4*)dst = w0; *(LAS u32x4*)(dst + CPITCH) = w1;
        }
        __syncthreads();
        {
            const int r = wid >> 1, pt = wid & 1;
            f32x16 acc[4] = {};
#pragma unroll
            for (int ks = 0; ks < 8; ++ks) {
                const bf16x8 af = *(const LAS bf16x8*)(XS + (r * 64 + pt * 32 + r32) * CPITCH + ks * 16 + hi * 8);
#pragma unroll
                for (int nt = 0; nt < 4; ++nt) { const bf16x8 bf = *(const LAS bf16x8*)(BT + (nt * 32 + r32) * CPITCH + ks * 16 + hi * 8); acc[nt] = MFMA32(af, bf, acc[nt]); }
            }
            float* sp = states + ((size_t)unit * 8 + g * 4 + r) * 8192;
#pragma unroll
            for (int nt = 0; nt < 4; ++nt)
#pragma unroll
                for (int j = 0; j < 16; ++j) sp[(pt * 32 + crow(j, hi)) * 128 + nt * 32 + r32] = acc[nt][j];
        }
        __syncthreads();
    }
}

__device__ __forceinline__ void scan_phase(const Frame& F) {
    float* states = (float*)(F.ws + WS_STATES); const float* cdec = (const float*)(F.ws + WS_CDEC);
    const int gt = F.bid * NTHR + F.tid, NT = F.G * NTHR;
    for (int idx = gt; idx < BATCH * 8 * 8192; idx += NT) {
        const int b = idx >> 16, hd = (idx >> 13) & 7, e = idx & 8191;
        float h = 0.f;
        for (int c0 = 0; c0 < NCHUNK; c0 += 8) {
            float st[8], dc[8];
#pragma unroll
            for (int i = 0; i < 8; ++i) { const size_t ch = (size_t)(b * NCHUNK + c0 + i) * 8 + hd; st[i] = states[ch * 8192 + e]; dc[i] = cdec[ch]; }
#pragma unroll
            for (int i = 0; i < 8; ++i) { const size_t ch = (size_t)(b * NCHUNK + c0 + i) * 8 + hd; states[ch * 8192 + e] = h; h = h * dc[i] + st[i]; }
        }
    }
}

__device__ __forceinline__ void c3_unit(const Frame& F, const Args& a, int layer, int unit) {
    const int b = unit / NCHUNK, c = unit % NCHUNK; const size_t rowbase = (size_t)b * SEQ; const int tc0 = c * 128;
    const bf16_t* proj = (const bf16_t*)(F.ws + WS_PROJ); bf16_t* mixo = (bf16_t*)(F.ws + WS_MIXO);
    const int tid = F.tid, lane = F.lane, wid = F.wave, r32 = lane & 31, hi = lane >> 5;
    const float* dtraw = (const float*)(F.ws + WS_DTRAW);
    __syncthreads();
    ssd_tables(F, dtraw, a.in[14] + layer * 8, a.in[15] + layer * 8, (int)rowbase + tc0);
    LAS float* dtv = (LAS float*)(F.lds + L_TAB_DT); LAS float* acs = (LAS float*)(F.lds + L_TAB_ACS); LAS float* part = (LAS float*)(F.lds + L_TAB_PART);
    const float* cw = a.in[12] + (size_t)layer * 4 * 1024; const float* cb = a.in[13] + (size_t)layer * 1024;
    LAS bf16_t* XS = (LAS bf16_t*)F.lds;
    LAS bf16_t* BM = (LAS bf16_t*)(F.lds + 256 * CPITCH * 2);
    LAS bf16_t* CM = (LAS bf16_t*)(F.lds + 384 * CPITCH * 2);
    const float* states = (const float*)(F.ws + WS_STATES);
    const int lt = wid & 3, hp = wid >> 2, l = lt * 32 + r32;
    for (int g = 0; g < 2; ++g) {
        for (int it = tid; it < 256 * 16; it += NTHR) {
            const int cpi = it & 255, oct = it >> 8;
            const int sec = cpi < 128 ? 0 : (cpi < 192 ? 1 : 2);
            const int chl = sec == 0 ? 2 * cpi : (sec == 1 ? 2 * (cpi - 128) : 2 * (cpi - 192));
            const int cch = sec == 0 ? g * 256 + chl : (sec == 1 ? 512 + g * 128 + chl : 768 + g * 128 + chl);
            float o0[8], o1[8];
            conv8(proj, cw, cb, rowbase, tc0 + oct * 8, cch, o0, o1);
            if (sec == 0) {
                LAS bf16_t* dst = XS + chl * CPITCH + oct * 8; u32x4 w0, w1;
                w0.x = pk2(o0[0], o0[1]); w0.y = pk2(o0[2], o0[3]); w0.z = pk2(o0[4], o0[5]); w0.w = pk2(o0[6], o0[7]);
                w1.x = pk2(o1[0], o1[1]); w1.y = pk2(o1[2], o1[3]); w1.z = pk2(o1[4], o1[5]); w1.w = pk2(o1[6], o1[7]);
                *(LAS u32x4*)dst = w0; *(LAS u32x4*)(dst + CPITCH) = w1;
            } else {
                LAS bf16_t* dst = (sec == 1 ? BM : CM) + (oct * 8) * CPITCH + chl;
#pragma unroll
                for (int j = 0; j < 8; ++j) *(LAS unsigned*)(dst + j * CPITCH) = pk2(o0[j], o1[j]);
            }
        }
        __syncthreads();
        f32x16 acc[2][2];
#pragma unroll
        for (int hh = 0; hh < 2; ++hh) {
            const int hd = g * 4 + hp * 2 + hh;
            const float* pv = states + ((size_t)unit * 8 + hd) * 8192;
#pragma unroll
            for (int pt = 0; pt < 2; ++pt) acc[hh][pt] = (f32x16){};
#pragma unroll
            for (int ks = 0; ks < 8; ++ks) {
                const bf16x8 cf = *(const LAS bf16x8*)(CM + l * CPITCH + ks * 16 + hi * 8);
#pragma unroll
                for (int pt = 0; pt < 2; ++pt) {
                    const float* pp = pv + (pt * 32 + r32) * 128 + ks * 16 + hi * 8;
                    const f32x4 p0 = *(const f32x4*)pp, p1 = *(const f32x4*)(pp + 4);
                    u32x4 w; w.x = pk2(p0[0], p0[1]); w.y = pk2(p0[2], p0[3]); w.z = pk2(p1[0], p1[1]); w.w = pk2(p1[2], p1[3]);
                    acc[hh][pt] = MFMA32(__builtin_bit_cast(bf16x8, w), cf, acc[hh][pt]);
                }
            }
            const float ea = __builtin_amdgcn_exp2f(acs[l * 8 + hd] * LOG2E);
#pragma unroll
            for (int pt = 0; pt < 2; ++pt)
#pragma unroll
                for (int j = 0; j < 16; ++j) acc[hh][pt][j] *= ea;
        }
        for (int st = 0; st <= lt; ++st) {
            f32x16 cbt = {};
#pragma unroll
            for (int ks = 0; ks < 8; ++ks) {
                const bf16x8 bf = *(const LAS bf16x8*)(BM + (st * 32 + r32) * CPITCH + ks * 16 + hi * 8);
                const bf16x8 cf = *(const LAS bf16x8*)(CM + l * CPITCH + ks * 16 + hi * 8);
                cbt = MFMA32(bf, cf, cbt);
            }
#pragma unroll
            for (int hh = 0; hh < 2; ++hh) {
                const int hd = g * 4 + hp * 2 + hh;
                const float al = acs[l * 8 + hd], dsk = a.in[16][layer * 8 + hd];
                float x[16];
#pragma unroll
                for (int j = 0; j < 16; ++j) { const int s = st * 32 + crow(j, hi);
                    const float e = __builtin_amdgcn_exp2f(fminf(al - acs[s * 8 + hd], 0.f) * LOG2E) * dtv[s * 8 + hd];
                    x[j] = (s <= l) ? cbt[j] * e : 0.f; if (s == l) x[j] += dsk; }
                u32x4 w0, w1;
                w0.x = pk2(x[0], x[1]); w0.y = pk2(x[2], x[3]); w0.z = pk2(x[4], x[5]); w0.w = pk2(x[6], x[7]);
                w1.x = pk2(x[8], x[9]); w1.y = pk2(x[10], x[11]); w1.z = pk2(x[12], x[13]); w1.w = pk2(x[14], x[15]);
                const bf16x8 xf0 = __builtin_bit_cast(bf16x8, w0), xf1 = __builtin_bit_cast(bf16x8, w1);
#pragma unroll
                for (int pt = 0; pt < 2; ++pt) {
                    const LAS bf16_t* xr = XS + ((hp * 2 + hh) * 64 + pt * 32 + r32) * CPITCH + st * 32 + 4 * hi;
                    const u32x2 a0 = *(const LAS u32x2*)(xr), a1 = *(const LAS u32x2*)(xr + 8), a2 = *(const LAS u32x2*)(xr + 16), a3 = *(const LAS u32x2*)(xr + 24);
                    const u32x4 f0 = {a0.x, a0.y, a1.x, a1.y}, f1 = {a2.x, a2.y, a3.x, a3.y};
                    acc[hh][pt] = MFMA32(__builtin_bit_cast(bf16x8, f0), xf0, acc[hh][pt]);
                    acc[hh][pt] = MFMA32(__builtin_bit_cast(bf16x8, f1), xf1, acc[hh][pt]);
                }
            }
        }
        float ssq = 0.f;
        const size_t orow = (rowbase + tc0 + l);
#pragma unroll
        for (int hh = 0; hh < 2; ++hh)
#pragma unroll
            for (int pt = 0; pt < 2; ++pt)
#pragma unroll
                for (int q = 0; q < 4; ++q) {
                    const int ch = g * 256 + (hp * 2 + hh) * 64 + pt * 32 + 8 * q + 4 * hi;
                    const u32x2 zz = *(const u32x2*)(proj + orow * NPROJ + C_Z + ch);
                    const float z0 = bflo(zz.x), z1 = bfhi(zz.x), z2 = bflo(zz.y), z3 = bfhi(zz.y);
                    const float y0 = acc[hh][pt][4 * q + 0] * z0 * fast_sigmoid(z0), y1 = acc[hh][pt][4 * q + 1] * z1 * fast_sigmoid(z1);
                    const float y2 = acc[hh][pt][4 * q + 2] * z2 * fast_sigmoid(z2), y3 = acc[hh][pt][4 * q + 3] * z3 * fast_sigmoid(z3);
                    ssq += (y0 * y0 + y1 * y1) + (y2 * y2 + y3 * y3);
                    u32x2 w; w.x = pk2(y0, y1); w.y = pk2(y2, y3);
                    *(u32x2*)(mixo + orow * DM + 512 + ch) = w;
                }
        ssq = xsum32(ssq);
        if (hi == 0) part[l * 4 + g * 2 + hp] = ssq;
        __syncthreads();
    }
    {
        const float* ng = a.in[17] + layer * 512;
        for (int it = tid; it < 128 * 64; it += NTHR) {
            const int row = it >> 6, cc = (it & 63) * 8;
            const float ss = (part[row * 4 + 0] + part[row * 4 + 1]) + (part[row * 4 + 2] + part[row * 4 + 3]);
            const float rinv = 1.0f / sqrtf(ss * (1.0f / 512.0f) + LN_EPS);
            bf16_t* p = mixo + (rowbase + tc0 + row) * DM + 512 + cc;
            const u32x4 t = *(const u32x4*)p; const f32x4 g0 = *(const f32x4*)(ng + cc), g1 = *(const f32x4*)(ng + cc + 4);
            u32x4 w;
            w.x = pk2(bflo(t.x) * rinv * g0[0], bfhi(t.x) * rinv * g0[1]); w.y = pk2(bflo(t.y) * rinv * g0[2], bfhi(t.y) * rinv * g0[3]);
            w.z = pk2(bflo(t.z) * rinv * g1[0], bfhi(t.z) * rinv * g1[1]); w.w = pk2(bflo(t.w) * rinv * g1[2], bfhi(t.w) * rinv * g1[3]);
            *(u32x4*)p = w;
        }
    }
    __syncthreads();
}

constexpr int KP = 72;
constexpr int L_KBUF = 0, L_VBUF = 2 * 64 * KP * 2;
__device__ __forceinline__ void attn_unit(const Frame& F, const Args& a, int layer, int b, int h, int qb) {
    const bf16_t* proj = (const bf16_t*)(F.ws + WS_PROJ); bf16_t* mixo = (bf16_t*)(F.ws + WS_MIXO);
    const int tid = F.tid, lane = F.lane, wid = F.wave, r32 = lane & 31, hi = lane >> 5;
    const size_t rowbase = (size_t)b * SEQ; const int q0 = qb * 256, qw0 = q0 + wid * 32, myq = qw0 + r32;
    LAS bf16_t* Kb = (LAS bf16_t*)(F.lds + L_KBUF); LAS bf16_t* Vb = (LAS bf16_t*)(F.lds + L_VBUF);
    bf16x8 qf[2][2];
    { const bf16_t* qp = proj + (rowbase + myq) * NPROJ + C_Q + h * 64 + hi * 8;
#pragma unroll
      for (int j = 0; j < 2; ++j)
#pragma unroll
        for (int ks = 0; ks < 2; ++ks) qf[j][ks] = *(const bf16x8*)(qp + j * 32 + ks * 16); }
    float negm;
    { float qn1 = 0.f, qn2 = 0.f;
#pragma unroll
      for (int ks = 0; ks < 2; ++ks)
#pragma unroll
        for (int e = 0; e < 8; ++e) { const float x1 = bf2f((unsigned short)qf[0][ks][e]), x2 = bf2f((unsigned short)qf[1][ks][e]); qn1 += x1 * x1; qn2 += x2 * x2; }
      qn1 = xsum32(qn1); qn2 = xsum32(qn2);
      const unsigned* km = (const unsigned*)(F.ws + WS_KMAX) + layer * 32 + b * 8 + h * 2;
      const float mm1 = -(sqrtf(qn1 * __uint_as_float(km[0])) * 1.01f + 1e-6f), mm2 = -(sqrtf(qn2 * __uint_as_float(km[1])) * 1.01f + 1e-6f);
      negm = fminf(mm1, mm2); }
    f32x16 o1[2], o2[2];
#pragma unroll
    for (int v = 0; v < 2; ++v) { o1[v] = (f32x16){}; o2[v] = (f32x16){}; }
    float l1 = 0.f, l2 = 0.f;
    const int NT = (q0 + 256) / 64;
    const bf16_t* kg = proj + (rowbase + (tid >> 3)) * NPROJ + C_K + h * 64 + (tid & 7) * 8;
    const bf16_t* vg = proj + (rowbase + lane) * NPROJ + C_V + h * 64 + wid * 8;
    LAS bf16_t* kdst = Kb + (tid >> 3) * KP + (tid & 7) * 8;
    LAS bf16_t* vdst = Vb + (wid * 8) * KP + lane;
    u32x4 kreg = *(const u32x4*)kg, vreg = *(const u32x4*)vg;
    __syncthreads();
    {
        *(LAS u32x4*)kdst = kreg;
        vdst[0 * KP] = (bf16_t)(vreg.x & 0xffffu); vdst[1 * KP] = (bf16_t)(vreg.x >> 16); vdst[2 * KP] = (bf16_t)(vreg.y & 0xffffu); vdst[3 * KP] = (bf16_t)(vreg.y >> 16);
        vdst[4 * KP] = (bf16_t)(vreg.z & 0xffffu); vdst[5 * KP] = (bf16_t)(vreg.z >> 16); vdst[6 * KP] = (bf16_t)(vreg.w & 0xffffu); vdst[7 * KP] = (bf16_t)(vreg.w >> 16);
    }
    __syncthreads();
    for (int t = 0; t < NT; ++t) {
        const int buf = t & 1;
        if (t + 1 < NT) { kreg = *(const u32x4*)(kg + (size_t)(t + 1) * 64 * NPROJ); vreg = *(const u32x4*)(vg + (size_t)(t + 1) * 64 * NPROJ); }
        const LAS bf16_t* Kt = Kb + buf * 64 * KP; const LAS bf16_t* Vt = Vb + buf * 64 * KP;
#pragma unroll
        for (int kb = 0; kb < 2; ++kb) {
            const int kbase = t * 64 + kb * 32;
            if (kbase <= qw0 + 31) {
                f32x16 s1, s2;
                {
                    const LAS bf16_t* kp = Kt + (kb * 32 + r32) * KP + hi * 8;
                    const bf16x8 k10 = *(const LAS bf16x8*)(kp), k11 = *(const LAS bf16x8*)(kp + 16), k20 = *(const LAS bf16x8*)(kp + 32), k21 = *(const LAS bf16x8*)(kp + 48);
                    s1 = MFMA32(k10, qf[0][0], (f32x16){}); s2 = MFMA32(k20, qf[1][0], (f32x16){});
                    s1 = MFMA32(k11, qf[0][1], s1); s2 = MFMA32(k21, qf[1][1], s2);
                }
                if (kbase + 31 > qw0) {
#pragma unroll
                    for (int j = 0; j < 16; ++j) { const int key = kbase + crow(j, hi); if (key > myq) { s1[j] = -INFINITY; s2[j] = -INFINITY; } }
                }
                float ps1 = 0.f, ps2 = 0.f;
#pragma unroll
                for (int j = 0; j < 16; ++j) { s1[j] = __builtin_amdgcn_exp2f(s1[j] + negm); s2[j] = __builtin_amdgcn_exp2f(s2[j] + negm); ps1 += s1[j]; ps2 += s2[j]; }
                l1 += ps1; l2 += ps2;
                bf16x8 p1[2], p2[2];
#pragma unroll
                for (int ks = 0; ks < 2; ++ks) {
                    u32x4 w; w.x = pk2(s1[8 * ks + 0], s1[8 * ks + 1]); w.y = pk2(s1[8 * ks + 2], s1[8 * ks + 3]); w.z = pk2(s1[8 * ks + 4], s1[8 * ks + 5]); w.w = pk2(s1[8 * ks + 6], s1[8 * ks + 7]);
                    p1[ks] = __builtin_bit_cast(bf16x8, w);
                    u32x4 y; y.x = pk2(s2[8 * ks + 0], s2[8 * ks + 1]); y.y = pk2(s2[8 * ks + 2], s2[8 * ks + 3]); y.z = pk2(s2[8 * ks + 4], s2[8 * ks + 5]); y.w = pk2(s2[8 * ks + 6], s2[8 * ks + 7]);
                    p2[ks] = __builtin_bit_cast(bf16x8, y);
                }
#pragma unroll
                for (int v = 0; v < 2; ++v)
#pragma unroll
                    for (int ks = 0; ks < 2; ++ks) {
                        const LAS bf16_t* vp = Vt + (v * 32 + r32) * KP + kb * 32 + ks * 16 + 4 * hi;
                        const u32x2 a0 = *(const LAS u32x2*)vp, a1 = *(const LAS u32x2*)(vp + 8);
                        const u32x4 f = {a0.x, a0.y, a1.x, a1.y}; const bf16x8 vf = __builtin_bit_cast(bf16x8, f);
                        o1[v] = MFMA32(vf, p1[ks], o1[v]); o2[v] = MFMA32(vf, p2[ks], o2[v]);
                    }
            }
        }
        if (t + 1 < NT) {
            LAS bf16_t* kd = kdst + (buf ^ 1) * 64 * KP; LAS bf16_t* vd = vdst + (buf ^ 1) * 64 * KP;
            *(LAS u32x4*)kd = kreg;
            vd[0 * KP] = (bf16_t)(vreg.x & 0xffffu); vd[1 * KP] = (bf16_t)(vreg.x >> 16); vd[2 * KP] = (bf16_t)(vreg.y & 0xffffu); vd[3 * KP] = (bf16_t)(vreg.y >> 16);
            vd[4 * KP] = (bf16_t)(vreg.z & 0xffffu); vd[5 * KP] = (bf16_t)(vreg.z >> 16); vd[6 * KP] = (bf16_t)(vreg.w & 0xffffu); vd[7 * KP] = (bf16_t)(vreg.w >> 16);
        }
        __syncthreads();
    }
    int layer2 = layer, myq2 = myq, h2 = h; asm volatile("" : "+s"(layer2), "+v"(myq2), "+s"(h2));
    float d1 = 0.f, d2 = 0.f;
#pragma unroll 8
    for (int i = 0; i < 32; ++i) { d1 += a.in[7][layer2 * 32 + i] * a.in[8][layer2 * 32 + i]; d2 += a.in[9][layer2 * 32 + i] * a.in[10][layer2 * 32 + i]; }
    float k08 = 0.8f, k06 = 0.6f; asm volatile("" : "+v"(k08), "+v"(k06));
    const float lam_init = k08 - k06 * expf(-0.3f * (float)layer2);
    const float lam = expf(d1) - expf(d2) + lam_init;
    l1 = xsum32(l1); l2 = xsum32(l2);
    const float i1 = 1.0f / l1, i2 = lam / l2;
    float ssq = 0.f;
#pragma unroll
    for (int v = 0; v < 2; ++v)
#pragma unroll
        for (int j = 0; j < 16; ++j) { const float o = o1[v][j] * i1 - o2[v][j] * i2; o1[v][j] = o; ssq += o * o; }
    ssq = xsum32(ssq);
    const float sc = (1.0f - lam_init) / sqrtf(ssq * (1.0f / 64.0f) + LN_EPS);
    const float* ng = a.in[11] + layer2 * 64;
    bf16_t* op = mixo + (rowbase + myq2) * DM + 256 + h2 * 64;
#pragma unroll
    for (int v = 0; v < 2; ++v)
#pragma unroll
        for (int q = 0; q < 4; ++q) {
            const int vd = v * 32 + 8 * q + 4 * (myq2 >= 0 ? hi : 0); const f32x4 g4 = *(const f32x4*)(ng + vd);
            u32x2 w; w.x = pk2(o1[v][4 * q + 0] * sc * g4[0], o1[v][4 * q + 1] * sc * g4[1]); w.y = pk2(o1[v][4 * q + 2] * sc * g4[2], o1[v][4 * q + 3] * sc * g4[3]);
            *(u32x2*)(op + vd) = w;
        }
}

#define RLX_AGENT __ATOMIC_RELAXED, __HIP_MEMORY_SCOPE_AGENT
#define XB_TMO      128
#define XB_XCNT(j)  (256  + 64 * (j))
#define XB_XSUB(j)  (1280 + 64 * (j))
#define XB_XGEN(j)  (2304 + 64 * (j))
#define XB_TOP      3328
#define XB_TOPGEN   3392
#define XCD_BAR_WORDS 3456
#define XB_SPIN_CAP (1u << 18)

__device__ __forceinline__ unsigned xb_ld(unsigned* p)              { return __hip_atomic_load(p, __ATOMIC_RELAXED, __HIP_MEMORY_SCOPE_AGENT); }
__device__ __forceinline__ unsigned xb_add(unsigned* p, unsigned v) { return __hip_atomic_fetch_add(p, v, __ATOMIC_RELAXED, __HIP_MEMORY_SCOPE_AGENT); }
__device__ __forceinline__ unsigned xb_xcc_id() { return (unsigned)__builtin_amdgcn_s_getreg((3 << 11) | 20) & 0xFu; }
#define XB_SPIN(cond, bar) do { unsigned _sp = 0; while (cond) { __builtin_amdgcn_s_sleep(1); \
    if ((++_sp & 255u) == 0u) { if (xb_ld(&(bar)[XB_TMO])) break; if (_sp > XB_SPIN_CAP) { atomicAdd(&(bar)[XB_TMO], 1u); break; } } } } while (0)

struct XcdBarrier {
    unsigned* bar; unsigned x;
    volatile LAS unsigned* st;
};

__device__ __forceinline__ XcdBarrier xcd_barrier_post(unsigned* bar, volatile LAS unsigned* st) {
    XcdBarrier b; b.bar = bar; b.x = xb_xcc_id(); b.st = st;
    if (threadIdx.x == 0) (void)xb_add(&bar[XB_XCNT(b.x)], 1u);
    return b;
}
__device__ __forceinline__ void xcd_barrier_complete(unsigned* bar, unsigned x, unsigned& nloc, unsigned& nx) {
    const unsigned G = gridDim.x * gridDim.y * gridDim.z;
    unsigned sum, cnt, mine, sp = 0u;
    for (;;) {
        sum = 0u; cnt = 0u; mine = 0u;
#pragma unroll
        for (unsigned j = 0; j < 16; ++j) { const unsigned c = xb_ld(&bar[XB_XCNT(j)]); sum += c; cnt += (c > 0u) ? 1u : 0u; mine = (j == x) ? c : mine; }
        if (sum == G) break;
        __builtin_amdgcn_s_sleep(1);
        if ((++sp & 255u) == 0u) { if (xb_ld(&bar[XB_TMO])) break; if (sp > XB_SPIN_CAP) { atomicAdd(&bar[XB_TMO], 1u); break; } }
    }
    nloc = mine > 0u ? mine : 1u; nx = cnt > 0u ? cnt : 1u;
}

__device__ __forceinline__ void xcd_barrier(const XcdBarrier& b) {
    asm volatile("s_waitcnt vmcnt(0)" ::: "memory");
    __syncthreads();
    if (threadIdx.x == 0) {
        unsigned* bar = b.bar;
        __builtin_amdgcn_s_waitcnt(0);
        unsigned nloc = b.st[0], nx = b.st[1];
        if (nloc == 0u) { xcd_barrier_complete(bar, b.x, nloc, nx); b.st[0] = nloc; b.st[1] = nx; }
        const unsigned old = xb_add(&bar[XB_XSUB(b.x)], 1u);
        const unsigned gen = old / nloc;
        if (old + 1u == (gen + 1u) * nloc) {
            __builtin_amdgcn_fence(__ATOMIC_RELEASE, "agent");
            asm volatile("s_waitcnt vmcnt(0)" ::: "memory");
            const unsigned og = xb_add(&bar[XB_TOP], 1u);
            const unsigned tg = og / nx;
            if (og + 1u == (tg + 1u) * nx) xb_add(&bar[XB_TOPGEN], 1u);
            else XB_SPIN(xb_ld(&bar[XB_TOPGEN]) == tg, bar);
            __builtin_amdgcn_fence(__ATOMIC_ACQUIRE, "agent");
            xb_add(&bar[XB_XGEN(b.x)], 1u);
            asm volatile("s_waitcnt vmcnt(0)" ::: "memory");
        } else {
            XB_SPIN(xb_ld(&bar[XB_XGEN(b.x)]) == gen, bar);
            __builtin_amdgcn_fence(__ATOMIC_ACQUIRE, "agent");
            asm volatile("s_waitcnt vmcnt(0)" ::: "memory");
        }
    }
    __syncthreads();
}

#ifndef MK_SPLIT
#define MK_SPLIT 0
#endif
constexpr int NPHASE = 1 + 9 * DEPTH;
__global__ void __launch_bounds__(NTHR, 2) fwd_megakernel(Args a) {
    extern __shared__ __attribute__((aligned(16))) unsigned char lds[];
    cg::grid_group grid = cg::this_grid();
    Frame F; F.probeN = 0;
    F.lds = (LAS unsigned char*)lds; F.ldsg = lds;
    F.tid = threadIdx.x; F.lane = F.tid & 63; F.wave = __builtin_amdgcn_readfirstlane(F.tid >> 6);
    F.G = gridDim.x; F.gw = blockIdx.x * NWAVES + F.wave; F.NGW = F.G * NWAVES; F.ws = a.ws;
    int vcu = (F.G % 8 == 0) ? ((int)blockIdx.x % 8) * (F.G / 8) + (int)blockIdx.x / 8 : (int)blockIdx.x;
    unsigned char* ws = a.ws;
#define HB ((bf16_t*)(ws + WS_HB))
#define PROJ ((bf16_t*)(ws + WS_PROJ))
#define MIXO ((bf16_t*)(ws + WS_MIXO))
#define FFA ((bf16_t*)(ws + WS_FFA))
#define PG ((bf16_t*)(ws + WS_PG))
#define STATS ((float*)(ws + WS_STATS))
#define DTRAW ((float*)(ws + WS_DTRAW))
#define WDT ((const unsigned*)(ws + WS_WDT))
#ifndef PHMASK
#define PHMASK 0x3ff
#endif
#define IN(k) (a.ph_lo <= (k) && (k) < a.ph_hi)
#define EN(i) ((PHMASK >> (i)) & 1)
#define FRESH() do { int t_ = threadIdx.x, b_ = blockIdx.x; asm volatile("" : "+v"(t_)); asm volatile("" : "+s"(b_)); F.tid = t_; F.lane = t_ & 63; F.wave = __builtin_amdgcn_readfirstlane(t_ >> 6); F.bid = b_; F.gw = b_ * NWAVES + F.wave; { unsigned char* w_ = a.ws; asm volatile("" : "+s"(w_)); ws = w_; F.ws = w_; } \
        vcu = (F.G % 8 == 0) ? (b_ % 8) * (F.G / 8) + b_ / 8 : b_; } while (0)
#ifndef PROBE_MASK
#define PROBE_MASK 0
#endif
#if PROBE_MASK
#define STAMP(i) do { if (blockIdx.x == 0 && threadIdx.x == 0) ((unsigned long long*)(ws + WS_TS))[i] = __builtin_amdgcn_s_memrealtime(); } while (0)
#else
#define STAMP(i) do {} while (0)
#endif
#define SEAM(k) do { if (IN(k) && IN((k) + 1)) { XcdBarrier xb_; xb_.bar = (unsigned*)(ws + WS_BAR); xb_.x = xb_xcc_id(); xb_.st = (volatile LAS unsigned*)(F.lds + LDS_MISC); xcd_barrier(xb_); } STAMP((k) + 1); } while (0)
    if (a.ph_lo < 0) grid.sync();
    if (threadIdx.x < 16) ((LAS unsigned*)(F.lds + LDS_MISC))[threadIdx.x] = 0u;
    __syncthreads();
    (void)xcd_barrier_post((unsigned*)(ws + WS_BAR), (volatile LAS unsigned*)(F.lds + LDS_MISC));
    STAMP(0);
    if (EN(0) && IN(0)) { FRESH(); p0_prologue(F, a); }
    SEAM(0);
    for (int layer = 0; layer < DEPTH; ++layer) {
        const int pb = 1 + 9 * layer;
#define wb (ws + WS_W + (size_t)layer * W_STRIDE)
        if (EN(1) && IN(pb + 0)) { FRESH();
            if (layer == 0) { dtraw_from_hb(F, HB, WDT, DTRAW); FRESH(); }
            pg8::Gemm g{HB, (const bf16_t*)(wb + W_IN), MTOK, NPROJ, DM}; pg8::StaticOrder S; S.init(MTOK, NPROJ, F.G, F.bid);
            EpiProj E{PROJ, (unsigned*)(ws + WS_KMAX) + layer * 32};
            pg8::gemm_phase<EpiProj, pg8::StaticOrder, true, true>(F.lds, g, S, E, F.tid);
        }
        SEAM(pb + 0);
        if (EN(2) && IN(pb + 1)) { FRESH(); for (int u = F.bid; u < BATCH * NCHUNK; u += F.G) pool_c1_unit(F, a, layer, u); }
        SEAM(pb + 1);
        if (EN(3) && IN(pb + 2)) { FRESH(); scan_phase(F); }
        SEAM(pb + 2);
        if (EN(4) && IN(pb + 3)) { FRESH();
            for (int v = vcu; v < 256; v += F.G) { const int bh = v >> 4, s = v & 15;
#pragma nounroll
                for (int i2 = 0; i2 < 2; ++i2) attn_unit(F, a, layer, bh >> 2, bh & 3, i2 ? s : 31 - s); }
            STAMP(40 + layer);
            FRESH(); for (int u = F.bid; u < BATCH * NCHUNK; u += F.G) c3_unit(F, a, layer, u);
        }
        SEAM(pb + 3);
        if (EN(5) && IN(pb + 4)) { FRESH();
            { pg8::Gemm g{MIXO, (const bf16_t*)(wb + W_OUT), MTOK, DM, DM}; pg8::StaticOrder S; S.init(MTOK, DM, F.G, F.bid);
              EpiResid E{layer == 0 ? a.in[0] : (const float*)a.out, a.out, STATS, layer == 0 ? a.in[2] : a.in[25], layer == 0 ? a.in[3] : a.in[26], nullptr};
              pg8::gemm_phase<EpiResid, pg8::StaticOrder, true, true>(F.lds, g, S, E, F.tid); }
            FRESH();
            { pg8::Gemm g{(const bf16_t*)(ws + WS_PB) + (size_t)layer * MTOK * PLED, (const bf16_t*)(wb + W_PLE), MTOK, DM, PLED}; pg8::StaticOrder S; S.init(MTOK, DM, F.G, F.bid);
              EpiStoreBf16 E{PG, DM};
              pg8::gemm_phase<EpiStoreBf16, pg8::StaticOrder, true, true>(F.lds, g, S, E, F.tid); }
        }
        SEAM(pb + 4);
        if (EN(6) && IN(pb + 5)) { FRESH(); ln_rows<false, false>(F, a.out, a.in[19] + layer * DM, a.in[20] + layer * DM, HB, STATS, nullptr, nullptr, nullptr); }
        SEAM(pb + 5);
        if (EN(7) && IN(pb + 6)) { FRESH();
            pg8::Gemm g{HB, (const bf16_t*)(wb + W_FF1G), MTOK, DFF + DM, DM}; pg8::StaticOrder S; S.init(MTOK, DFF + DM, F.G, F.bid);
            EpiFf1Gate E{FFA, PG};
            pg8::gemm_phase<EpiFf1Gate, pg8::StaticOrder, true, true>(F.lds, g, S, E, F.tid);
        }
        SEAM(pb + 6);
        if (EN(8) && IN(pb + 7)) { FRESH();
            pg8::Gemm g{FFA, (const bf16_t*)(wb + W_FF2), MTOK, DM, DFF}; pg8::StaticOrder S; S.init(MTOK, DM, F.G, F.bid);
            EpiResid E{(const float*)a.out, a.out, STATS, a.in[19] + layer * DM, a.in[20] + layer * DM, PG};
            pg8::gemm_phase<EpiResid, pg8::StaticOrder, true, true>(F.lds, g, S, E, F.tid);
        }
#if PROBE_MASK
        if (layer == DEPTH - 1 && blockIdx.x == 0 && threadIdx.x == 0) {
            const unsigned long long* ts = (const unsigned long long*)(ws + WS_TS); unsigned long long now = __builtin_amdgcn_s_memrealtime(), tot = 0;
            for (int p = 0; p < NPHASE - 1; ++p) { const int cat = p == 0 ? 0 : 1 + (p - 1) % 9; const unsigned long long t1 = (p == NPHASE - 2) ? now : ts[p + 1];
                if ((PROBE_MASK >> cat) & 1) tot += t1 - ts[p];
                if (cat == 4 && ((PROBE_MASK >> 10) & 1)) tot += ts[40 + (p - 1) / 9] - ts[p]; }
            *(unsigned*)(ws + WS_TS + 1024) = (unsigned)(tot * 16 / 100);
        }
#endif
        SEAM(pb + 7);
        if (EN(9) && IN(pb + 8)) { FRESH();
            if (layer + 1 < DEPTH) ln_rows<false, true>(F, a.out, a.in[25] + layer * DM, a.in[26] + layer * DM, HB, STATS, WDT + (size_t)(layer + 1) * 8 * 512, DTRAW, nullptr);
            else {
#if PROBE_MASK
                F.probeN = *(const unsigned*)(ws + WS_TS + 1024);
#endif
                ln_rows<true, false>(F, a.out, a.in[25] + layer * DM, a.in[26] + layer * DM, nullptr, nullptr, nullptr, nullptr, a.out); }
        }
        if (layer + 1 < DEPTH) SEAM(pb + 8);
    }
#undef IN
#undef SEAM
}

extern "C" void kernel_launch(void* const* d_in, const int* in_sizes, int n_in, void* d_out, int out_size, void* d_ws, size_t ws_size, hipStream_t stream) {
    static int grid = 0;
    if (grid == 0) {
        if (n_in != 27 || out_size != MTOK * DM || ws_size < WS_END) { fprintf(stderr, "kernel_launch: unexpected shapes (n_in %d out %d ws %zu)\n", n_in, out_size, ws_size); grid = -1; return; }
        int dev = 0, cus = 0, per_cu = 0;
        (void)hipGetDevice(&dev); (void)hipDeviceGetAttribute(&cus, hipDeviceAttributeMultiprocessorCount, dev);
        if (hipFuncSetAttribute((const void*)fwd_megakernel, hipFuncAttributeMaxDynamicSharedMemorySize, LDS_BYTES) != hipSuccess) { fprintf(stderr, "kernel_launch: hipFuncSetAttribute failed\n"); grid = -1; return; }
        if (hipOccupancyMaxActiveBlocksPerMultiprocessor(&per_cu, (const void*)fwd_megakernel, NTHR, LDS_BYTES) != hipSuccess || per_cu < 1) per_cu = 1;
        (void)hipGetLastError();
        grid = cus * per_cu; if (grid > 256) grid = 256; if (grid < 1) grid = 1;
    }
    if (grid < 0) return;
    if (hipMemsetAsync((char*)d_ws + WS_BAR, 0, BAR_BYTES, stream) != hipSuccess) { fprintf(stderr, "kernel_launch: memset failed\n"); return; }
    Args a{};
    for (int i = 0; i < 27; ++i) a.in[i] = (const float*)d_in[i];
    a.out = (float*)d_out; a.ws = (unsigned char*)d_ws;
#if MK_SPLIT
    for (int ph = 0; ph < NPHASE; ++ph) { a.ph_lo = ph; a.ph_hi = ph + 1; void* args[] = {&a};
        hipError_t e = hipLaunchCooperativeKernel((const void*)fwd_megakernel, dim3(grid), dim3(NTHR), args, LDS_BYTES, stream);
        if (e != hipSuccess) { fprintf(stderr, "launch %d failed: %s\n", ph, hipGetErrorString(e)); break; } }
#else
    a.ph_lo = 0; a.ph_hi = NPHASE; void* args[] = {&a};
    hipError_t e = hipLaunchCooperativeKernel((const void*)fwd_megakernel, dim3(grid), dim3(NTHR), args, LDS_BYTES, stream);
    if (e != hipSuccess) fprintf(stderr, "cooperative launch failed: %s (grid %d)\n", hipGetErrorString(e), grid);
#endif
}
```
